# Optimizing an MI355X kernel written in HIP

```python
import math
import jax, jax.numpy as jnp
from jax import lax
import numpy as np

D_MODEL = 1024
BATCH = 4
SEQ = 4096
DEPTH = 2

PLE_DIM = 256
BLOCK = 128
EPS = 1e-6
ROPE_THETA = 10000.0

MLA_HEADS = 8
MLA_Q_LORA = 384
MLA_KV_LORA = 256
MLA_NOPE = 64
MLA_ROPE = 32
MLA_V = 64
MLA_IN = MLA_Q_LORA + MLA_KV_LORA + MLA_ROPE
MLA_OUT = MLA_HEADS * MLA_V

DIFF_HEADS = 4
DIFF_QK = 64
DIFF_V = 2 * DIFF_QK
DIFF_QK_W = DIFF_HEADS * 2 * DIFF_QK
DIFF_IN = 2 * DIFF_QK_W + DIFF_HEADS * DIFF_V
DIFF_OUT = DIFF_HEADS * DIFF_V

SB_HEADS = 8
SB_DIM = 64
SB_W = SB_HEADS * SB_DIM
SB_IN = 3 * SB_W
SB_OUT = SB_W

D_IN = MLA_IN + DIFF_IN + SB_IN
N_BRANCH = 3
D_FF = 2816

kernel_name = "hybrid_mla_diff_stickbreak_macaron_ple"


def rms_norm(x, g):
    xf = x.astype(jnp.float32)
    y = xf * lax.rsqrt(jnp.mean(xf * xf, axis=-1, keepdims=True) + EPS)
    return (y * g.astype(jnp.float32)).astype(x.dtype)


def swiglu(x, w1, w3, w2):
    return (jax.nn.silu(x @ w1) * (x @ w3)) @ w2


def rope(x, pos):
    half = x.shape[-1] // 2
    freqs = 1.0 / (ROPE_THETA ** (jnp.arange(half, dtype=jnp.float32) / half))
    ang = pos.astype(jnp.float32)[:, None] * freqs[None, :]
    cos = jnp.cos(ang)[:, None, :]
    sin = jnp.sin(ang)[:, None, :]
    xf = x.astype(jnp.float32)
    x1, x2 = xf[..., :half], xf[..., half:]
    return jnp.concatenate([x1 * cos - x2 * sin, x2 * cos + x1 * sin], axis=-1).astype(x.dtype)


def to_blocks(t):
    b, s = t.shape[:2]
    t = t.reshape((b, s // BLOCK, BLOCK) + t.shape[2:])
    return jnp.moveaxis(t, 1, 0)


def from_blocks(t):
    t = jnp.moveaxis(t, 0, 1)
    return t.reshape((t.shape[0], t.shape[1] * t.shape[2]) + t.shape[3:])


def mla_branch(z, g_cq, g_ckv, w_uq, w_ukv, pos, blk_ids):
    b, s, _ = z.shape
    c_q = z[..., :MLA_Q_LORA]
    c_kv = z[..., MLA_Q_LORA:MLA_Q_LORA + MLA_KV_LORA]
    k_rope = z[..., MLA_Q_LORA + MLA_KV_LORA:]
    q = (rms_norm(c_q, g_cq) @ w_uq).reshape(b, s, MLA_HEADS, MLA_NOPE + MLA_ROPE)
    q_nope = q[..., :MLA_NOPE]
    q_rope = rope(q[..., MLA_NOPE:], pos)
    kv = (rms_norm(c_kv, g_ckv) @ w_ukv).reshape(b, s, MLA_HEADS, MLA_NOPE + MLA_V)
    k_nope, v = kv[..., :MLA_NOPE], kv[..., MLA_NOPE:]
    k_rope = rope(k_rope[:, :, None, :], pos)[:, :, 0, :]
    scale = (MLA_NOPE + MLA_ROPE) ** -0.5

    def block(args):
        qn, qr, blk = args
        qpos = blk * BLOCK + jnp.arange(BLOCK)
        sc = (jnp.einsum('bqhd,bkhd->bhqk', qn, k_nope)
              + jnp.einsum('bqhr,bkr->bhqk', qr, k_rope)).astype(jnp.float32) * scale
        sc = jnp.where(pos[None, :] <= qpos[:, None], sc, -jnp.inf)
        pr = jax.nn.softmax(sc, axis=-1).astype(v.dtype)
        return jnp.einsum('bhqk,bkhd->bqhd', pr, v)

    o = from_blocks(lax.map(block, (to_blocks(q_nope), to_blocks(q_rope), blk_ids)))
    return o.reshape(b, s, MLA_OUT)


def diff_branch(z, lq1, lk1, lq2, lk2, g_subln, lam_init, pos, blk_ids):
    b, s, _ = z.shape
    q = z[..., :DIFF_QK_W].reshape(b, s, DIFF_HEADS, 2, DIFF_QK)
    k = z[..., DIFF_QK_W:2 * DIFF_QK_W].reshape(b, s, DIFF_HEADS, 2, DIFF_QK)
    v = z[..., 2 * DIFF_QK_W:].reshape(b, s, DIFF_HEADS, DIFF_V)
    f32 = jnp.float32
    lam = (jnp.exp(jnp.sum(lq1.astype(f32) * lk1.astype(f32)))
           - jnp.exp(jnp.sum(lq2.astype(f32) * lk2.astype(f32))) + lam_init)
    head_idx = jnp.arange(1, DIFF_HEADS + 1, dtype=f32)
    slopes = jnp.exp2(-8.0 * head_idx / DIFF_HEADS)
    scale = DIFF_QK ** -0.5

    def block(args):
        qb, blk = args
        qpos = blk * BLOCK + jnp.arange(BLOCK)
        dist = (qpos[:, None] - pos[None, :]).astype(f32)
        bias = -slopes[:, None, None] * dist
        sc = jnp.einsum('bqhcd,bkhcd->bchqk', qb, k).astype(f32) * scale + bias
        sc = jnp.where(dist >= 0, sc, -jnp.inf)
        pr = jax.nn.softmax(sc, axis=-1)
        a = (pr[:, 0] - lam * pr[:, 1]).astype(v.dtype)
        return jnp.einsum('bhqk,bkhd->bqhd', a, v)

    o = from_blocks(lax.map(block, (to_blocks(q), blk_ids)))
    o = rms_norm(o, g_subln) * (1.0 - lam_init)
    return o.reshape(b, s, DIFF_OUT)


def stick_breaking_branch(z, pos, blk_ids):
    b, s, _ = z.shape
    q = z[..., :SB_W].reshape(b, s, SB_HEADS, SB_DIM)
    k = z[..., SB_W:2 * SB_W].reshape(b, s, SB_HEADS, SB_DIM)
    v = z[..., 2 * SB_W:].reshape(b, s, SB_HEADS, SB_DIM)
    scale = SB_DIM ** -0.5

    def block(args):
        qb, blk = args
        qpos = blk * BLOCK + jnp.arange(BLOCK)
        logits = jnp.einsum('bqhd,bkhd->bhqk', qb, k).astype(jnp.float32) * scale
        strict = pos[None, :] < qpos[:, None]
        log_beta = jax.nn.log_sigmoid(logits)
        log_1m = jnp.where(strict, jax.nn.log_sigmoid(-logits), 0.0)
        suffix = lax.cumsum(log_1m, axis=3, reverse=True) - log_1m
        w = jnp.where(strict, jnp.exp(log_beta + suffix), 0.0).astype(v.dtype)
        return jnp.einsum('bhqk,bkhd->bqhd', w, v)

    o = from_blocks(lax.map(block, (to_blocks(q), blk_ids)))
    return o.reshape(b, s, SB_OUT)


def hybrid_mixer(u, w_in, g_cq, g_ckv, w_uq, w_ukv, lq1, lk1, lq2, lk2, g_subln,
                 w_o_mla, w_o_diff, w_o_sb, w_branch_gate, w_out, lam_init):
    b, s, _ = u.shape
    pos = jnp.arange(s)
    blk_ids = jnp.arange(s // BLOCK)
    z = u @ w_in
    z_mla = z[..., :MLA_IN]
    z_diff = z[..., MLA_IN:MLA_IN + DIFF_IN]
    z_sb = z[..., MLA_IN + DIFF_IN:]
    y_mla = mla_branch(z_mla, g_cq, g_ckv, w_uq, w_ukv, pos, blk_ids)
    y_diff = diff_branch(z_diff, lq1, lk1, lq2, lk2, g_subln, lam_init, pos, blk_ids)
    y_sb = stick_breaking_branch(z_sb, pos, blk_ids)
    gates = jax.nn.sigmoid(u @ w_branch_gate).reshape(b, s, N_BRANCH, D_MODEL)
    merged = (gates[:, :, 0] * (y_mla @ w_o_mla)
              + gates[:, :, 1] * (y_diff @ w_o_diff)
              + gates[:, :, 2] * (y_sb @ w_o_sb))
    return merged @ w_out


def setup_inputs(seed: int = 0) -> dict:
    key = jax.random.key(seed)
    counter = [0]

    def nk():
        counter[0] += 1
        return jax.random.fold_in(key, counter[0])

    def dense(shape, fan_in, gain=1.0):
        return jax.random.normal(nk(), shape, jnp.float32) * (gain * fan_in ** -0.5)

    def norm_gain(shape):
        return 1.0 + 0.02 * jax.random.normal(nk(), shape, jnp.float32)

    def small(shape, std):
        return std * jax.random.normal(nk(), shape, jnp.float32)

    L = DEPTH
    return {
        "x": jax.random.normal(nk(), (BATCH, SEQ, D_MODEL), jnp.float32),
        "p": jax.random.normal(nk(), (DEPTH, BATCH, SEQ, PLE_DIM), jnp.float32),
        "g_ffn1": norm_gain((L, D_MODEL)),
        "w1_a": dense((L, D_MODEL, D_FF), D_MODEL),
        "w3_a": dense((L, D_MODEL, D_FF), D_MODEL),
        "w2_a": dense((L, D_FF, D_MODEL), D_FF),
        "g_mix": norm_gain((L, D_MODEL)),
        "w_in": dense((L, D_MODEL, D_IN), D_MODEL),
        "g_cq": norm_gain((L, MLA_Q_LORA)),
        "g_ckv": norm_gain((L, MLA_KV_LORA)),
        "w_uq": dense((L, MLA_Q_LORA, MLA_HEADS * (MLA_NOPE + MLA_ROPE)), MLA_Q_LORA),
        "w_ukv": dense((L, MLA_KV_LORA, MLA_HEADS * (MLA_NOPE + MLA_V)), MLA_KV_LORA),
        "lambda_q1": small((L, DIFF_QK), 0.1),
        "lambda_k1": small((L, DIFF_QK), 0.1),
        "lambda_q2": small((L, DIFF_QK), 0.1),
        "lambda_k2": small((L, DIFF_QK), 0.1),
        "g_subln": norm_gain((L, DIFF_V)),
        "w_o_mla": dense((L, MLA_OUT, D_MODEL), MLA_OUT),
        "w_o_diff": dense((L, DIFF_OUT, D_MODEL), DIFF_OUT),
        "w_o_sb": dense((L, SB_OUT, D_MODEL), SB_OUT),
        "w_branch_gate": dense((L, D_MODEL, N_BRANCH * D_MODEL), D_MODEL),
        "w_out": dense((L, D_MODEL, D_MODEL), D_MODEL),
        "g_ffn2": norm_gain((L, D_MODEL)),
        "w1_b": dense((L, D_MODEL, D_FF), D_MODEL),
        "w3_b": dense((L, D_MODEL, D_FF), D_MODEL),
        "w2_b": dense((L, D_FF, D_MODEL), D_FF),
        "g_ple": norm_gain((L, D_MODEL)),
        "w_ple_gate": dense((L, D_MODEL, D_MODEL), D_MODEL),
        "w_ple_proj": dense((L, PLE_DIM, D_MODEL), PLE_DIM),
        "g_final": norm_gain((D_MODEL,)),
    }


def reference(x, p, g_ffn1, w1_a, w3_a, w2_a, g_mix, w_in, g_cq, g_ckv, w_uq, w_ukv,
              lambda_q1, lambda_k1, lambda_q2, lambda_k2, g_subln, w_o_mla, w_o_diff, w_o_sb,
              w_branch_gate, w_out, g_ffn2, w1_b, w3_b, w2_b, g_ple, w_ple_gate, w_ple_proj,
              g_final):
    h = x
    for i in range(DEPTH):
        lam_init = 0.8 - 0.6 * math.exp(-0.3 * i)
        h = h + 0.5 * swiglu(rms_norm(h, g_ffn1[i]), w1_a[i], w3_a[i], w2_a[i])
        u = rms_norm(h, g_mix[i])
        h = h + hybrid_mixer(u, w_in[i], g_cq[i], g_ckv[i], w_uq[i], w_ukv[i],
                             lambda_q1[i], lambda_k1[i], lambda_q2[i], lambda_k2[i], g_subln[i],
                             w_o_mla[i], w_o_diff[i], w_o_sb[i], w_branch_gate[i], w_out[i],
                             lam_init)
        h = h + 0.5 * swiglu(rms_norm(h, g_ffn2[i]), w1_b[i], w3_b[i], w2_b[i])
        ple_gate = jax.nn.sigmoid(rms_norm(h, g_ple[i]) @ w_ple_gate[i])
        h = h + ple_gate * (p[i] @ w_ple_proj[i])
    return rms_norm(h, g_final)
```

```cpp
#include <hip/hip_runtime.h>
#include <hip/hip_cooperative_groups.h>
#include <cstdio>
#include <cstdint>
#include <cmath>
namespace cg = cooperative_groups;

#ifndef NAIVE_GEMM
#define NAIVE_GEMM 0
#endif
#ifndef NAIVE_ATTN
#define NAIVE_ATTN 0
#endif
#ifndef N_LAUNCH_MODE
#define N_LAUNCH_MODE 1
#endif

#define PG8_LAS __attribute__((address_space(3)))
#define LAS __attribute__((address_space(3)))
#define GAS __attribute__((address_space(1)))
typedef unsigned short bf16_t;
typedef short bf16x8 __attribute__((ext_vector_type(8)));
typedef float f32x4 __attribute__((ext_vector_type(4)));
typedef float f32x2 __attribute__((ext_vector_type(2)));
typedef float f32x16 __attribute__((ext_vector_type(16)));
typedef unsigned u32x4 __attribute__((ext_vector_type(4)));
typedef unsigned u32x2 __attribute__((ext_vector_type(2)));
typedef short v4i16_t __attribute__((ext_vector_type(4)));

constexpr int BATCH = 4, SEQ = 4096, TOK = BATCH * SEQ, DM = 1024, FF = 2816, PLE = 256;
constexpr float EPS = 1e-6f, LOG2E = 1.4426950408889634f, LN2 = 0.6931471805599453f;
constexpr size_t MiB = 1u << 20;
constexpr size_t WS_CTL = 0, CTL_BYTES = 4096;
constexpr size_t WS_ROPE = 1 * MiB;
constexpr size_t WS_STATS0 = 2 * MiB, WS_STATS1 = 3 * MiB;
constexpr size_t WS_STATQ = 4 * MiB;
constexpr size_t WS_WB = 6 * MiB;
constexpr size_t WS_HB = 66 * MiB;
constexpr size_t WS_PBF = 98 * MiB;
constexpr size_t WS_ZA = 106 * MiB;
constexpr size_t WS_QM = 130 * MiB;
constexpr size_t WS_QB = 154 * MiB;
constexpr size_t WS_QC = 170 * MiB, WS_KB = 186 * MiB, WS_VB = 202 * MiB, WS_KC = 218 * MiB, WS_VC = 234 * MiB;
constexpr size_t WS_KVM = 250 * MiB;
constexpr size_t WS_X = 186 * MiB;
constexpr size_t WS_FFH = 186 * MiB;
constexpr size_t WS_PE = 106 * MiB;
constexpr size_t WS_HB2 = 154 * MiB;
constexpr size_t WS_XM = 282 * MiB;
constexpr size_t WS_END = 314 * MiB;
constexpr size_t W_UPA = 0, W_DNA = 5767168, W_IN = 8650752, W_GATE = 12582912, W_UQ = 15728640, W_UKV = 16023552, W_O = 16285696,
                 W_OUT3 = 17858560, W_UPB = 21004288, W_DNB = 26771456, W_PG = 29655040, W_PE = 30703616, W_TOTAL = 30965760;
static_assert(WS_WB + W_TOTAL * 2 <= WS_HB, "weights fit");

typedef __bf16 bf16x2_t __attribute__((ext_vector_type(2)));
__device__ __forceinline__ unsigned cvt_pk(float lo, float hi) { f32x2 v = {lo, hi}; bf16x2_t b = __builtin_convertvector(v, bf16x2_t); return __builtin_bit_cast(unsigned, b); }
__device__ __forceinline__ float bflo(unsigned w) { return __uint_as_float(w << 16); }
__device__ __forceinline__ float bfhi(unsigned w) { return __uint_as_float(w & 0xffff0000u); }
__device__ __forceinline__ float bf2f(bf16_t b) { return __uint_as_float((unsigned)b << 16); }
__device__ __forceinline__ float fsigmoid(float x) { return __builtin_amdgcn_rcpf(1.0f + __builtin_amdgcn_exp2f(-x * LOG2E)); }
__device__ __forceinline__ float wave_sum(float v) {
#pragma unroll
    for (int o = 1; o < 64; o <<= 1) v += __shfl_xor(v, o);
    return v;
}

namespace pg8 {
constexpr int BM = 256, BK = 64, HALF = 128, HTB = HALF * BK * 2, STAGE_BYTES = 8 * HTB, NXCD = 8, WGM = 4;
__host__ __device__ __forceinline__ int lds_byte(int r, int c) { const int st = (r >> 4) * 2 + (c >> 5), rr = r & 15, cc = c & 31, ob = rr * 64 + cc * 2; return st * 1024 + (ob ^ (((ob >> 9) & 1) << 5)); }
__host__ __device__ __forceinline__ void stage_rc(int b, int& R, int& C) { const int st = b / 1024, sb = b % 1024, swz = sb ^ (((sb >> 9) & 1) << 5); R = (st >> 1) * 16 + swz / 64; C = (st & 1) * 32 + (swz % 64) / 2; }
__host__ __device__ __forceinline__ int perm32(int rho) { const int n = rho >> 4, i = rho & 15; return 8 * (i >> 2) + 4 * n + (i & 3); }

struct Unit { int pm, pn; };
struct Gemm { const bf16_t* A; const bf16_t* Bt; int M, N, K, lda; };

struct StaticOrder {
    int nM, nN, nwg, G, c;
    __host__ __device__ void init(int M, int N, int G_, int c_) { nM = M / BM; nN = N / BM; nwg = nM * nN; G = G_; c = c_; }
    __host__ __device__ bool next(int i, Unit& u) const {
        const long L = (long)i * G + c; if (L >= nwg) return false;
        int wgid = (int)L; { const int q = nwg / NXCD, r = nwg % NXCD, xcd = wgid % NXCD, off = wgid / NXCD; wgid = (xcd < r ? xcd * (q + 1) : r * (q + 1) + (xcd - r) * q) + off; }
        const int nig = WGM * nN, gid = wgid / nig, fm = gid * WGM, gsz = (nM - fm) < WGM ? (nM - fm) : WGM;
        u.pm = fm + ((wgid % nig) % gsz); u.pn = (wgid % nig) / gsz; return true;
    }
    __device__ __forceinline__ void a_ready(const Unit&) const {}
    __device__ __forceinline__ void done(const Unit&) const {}
};
struct PanelOrder {
    int pm, pn0, step, cnt;
    __device__ bool next(int i, Unit& u) const { if (i >= cnt) return false; u.pm = pm; u.pn = pn0 + step * i; return true; }
    __device__ __forceinline__ void a_ready(const Unit&) const {}
    __device__ __forceinline__ void done(const Unit&) const {}
};
template <class Epi, class Sched, bool ALIGN_EPI = false, bool SP2 = false>
__device__ __forceinline__ void gemm_phase(PG8_LAS unsigned char* lds, const Gemm g, const Sched& S, const Epi& E) {
    int tid_ = threadIdx.x; asm volatile("" : "+v"(tid_));
    const int tid = tid_, wid = __builtin_amdgcn_readfirstlane(tid >> 6), lane = tid & 63, wr = wid >> 2, wc = wid & 3, fr = lane & 15, fq = lane >> 4;
    const int K = g.K, nt = K / BK;
    unsigned voffA[2], voffB[2];
#pragma unroll
    for (int i = 0; i < 2; ++i) { int R, C; stage_rc(tid * 16 + i * 8192, R, C); const int Rb = Epi::PERM ? ((R & ~31) + perm32(R & 31)) : R;
        voffA[i] = (unsigned)(R * g.lda + C) * 2u; voffB[i] = (unsigned)(Rb * K + C) * 2u; }
    const size_t kstep = (size_t)(BK * 2);
    const size_t hstepA = (size_t)HALF * g.lda * 2, hstepB = (size_t)HALF * K * 2;
    const size_t tstepA = 2 * hstepA, tstepB = 2 * hstepB;
    const unsigned ldsw = (unsigned)wid * 1024u;
    const int aoff = lds_byte(wr * 64 + fr, fq * 8), boff = lds_byte(wc * 32 + fr, fq * 8);
#define PG8_SA(b, h) (((b) * 2 + (h)) * HTB)
#define PG8_SB(b, h) ((4 + (b) * 2 + (h)) * HTB)
#define PG8_STAGE(bufoff, gbase, voff) do { _Pragma("unroll") for (int _i = 0; _i < 2; ++_i) \
        __builtin_amdgcn_global_load_lds((const unsigned*)((const char*)(gbase) + (voff)[_i]), (PG8_LAS unsigned*)(lds + (bufoff) + ldsw + _i * 8192), 16, 0, 0); } while (0)
#define PG8_LDA(dst, b, h) do { _Pragma("unroll") for (int m = 0; m < 4; ++m) _Pragma("unroll") for (int k = 0; k < 2; ++k) dst[m][k] = *(const PG8_LAS bf16x8*)(lds + PG8_SA(b, h) + aoff + m * 2048 + k * 1024); } while (0)
#define PG8_LDB(dst, b, h) do { _Pragma("unroll") for (int n = 0; n < 2; ++n) _Pragma("unroll") for (int k = 0; k < 2; ++k) dst[n][k] = *(const PG8_LAS bf16x8*)(lds + PG8_SB(b, h) + boff + n * 2048 + k * 1024); } while (0)
#define PG8_MMA(ai, bj, At, Bt) do { __builtin_amdgcn_s_setprio(1); _Pragma("unroll") for (int m = 0; m < 4; ++m) _Pragma("unroll") for (int n = 0; n < 2; ++n) _Pragma("unroll") for (int k = 0; k < 2; ++k) \
        acc[ai][bj][m][n] = __builtin_amdgcn_mfma_f32_16x16x32_bf16(Bt[n][k], At[m][k], acc[ai][bj][m][n], 0, 0, 0); __builtin_amdgcn_s_setprio(0); } while (0)
#define PG8_WAIT_V(n) asm volatile("s_waitcnt vmcnt(" #n ")" ::: "memory")
#define PG8_WAIT_L(n) asm volatile("s_waitcnt lgkmcnt(" #n ")" ::: "memory")
#define PG8_BAR __builtin_amdgcn_s_barrier()
#define PG8_SCHED __builtin_amdgcn_sched_barrier(0)
    Unit cur, nxt; int ui = 0;
    if (!S.next(0, cur)) return;
    f32x4 acc[2][2][4][2];
#pragma unroll
    for (int a = 0; a < 2; ++a)
#pragma unroll
        for (int b = 0; b < 2; ++b)
#pragma unroll
            for (int m = 0; m < 4; ++m)
#pragma unroll
                for (int n = 0; n < 2; ++n) acc[a][b][m][n] = (f32x4){0.f, 0.f, 0.f, 0.f};
    bf16x8 At[4][2], B0[2][2], B1[2][2];
    const char* cA = (const char*)g.A + (size_t)cur.pm * tstepA; const char* cB = (const char*)g.Bt + (size_t)cur.pn * tstepB;
    S.a_ready(cur);
    if constexpr (SP2) {
        PG8_STAGE(PG8_SB(0, 0), cB, voffB); PG8_STAGE(PG8_SB(0, 1), cB + hstepB, voffB); PG8_STAGE(PG8_SA(0, 0), cA, voffA); PG8_STAGE(PG8_SA(0, 1), cA + hstepA, voffA);
        if (wr == 1) PG8_BAR;
        PG8_WAIT_V(2); PG8_BAR;
        PG8_STAGE(PG8_SB(1, 0), cB + kstep, voffB); PG8_STAGE(PG8_SA(1, 0), cA + kstep, voffA); PG8_STAGE(PG8_SB(1, 1), cB + hstepB + kstep, voffB);
        PG8_WAIT_V(6); PG8_BAR;
    } else {
        PG8_STAGE(PG8_SB(0, 0), cB, voffB); PG8_STAGE(PG8_SA(0, 0), cA, voffA); PG8_STAGE(PG8_SB(0, 1), cB + hstepB, voffB); PG8_STAGE(PG8_SA(0, 1), cA + hstepA, voffA);
        if (wr == 1) PG8_BAR;
        PG8_WAIT_V(4); PG8_BAR;
        PG8_STAGE(PG8_SB(1, 0), cB + kstep, voffB); PG8_STAGE(PG8_SA(1, 0), cA + kstep, voffA); PG8_STAGE(PG8_SB(1, 1), cB + hstepB + kstep, voffB);
        PG8_WAIT_V(6); PG8_BAR;
    }
    for (;;) {
        const bool has_next = S.next(ui + 1, nxt);
        const char* nA = has_next ? (const char*)g.A + (size_t)nxt.pm * tstepA : cA; const char* nB = has_next ? (const char*)g.Bt + (size_t)nxt.pn * tstepB : cB;
        for (int t = 0; t < nt; t += 2) {
            const bool last = (t == nt - 2);
            const char* a1 = cA + (size_t)(t + 1) * kstep;
            const char* a2 = last ? nA : cA + (size_t)(t + 2) * kstep; const char* b2 = last ? nB : cB + (size_t)(t + 2) * kstep;
            const char* a3 = a2 + kstep; const char* b3 = b2 + kstep;
            if (last && has_next) S.a_ready(nxt);
            if constexpr (SP2) {
            PG8_LDB(B0, 0, 0); PG8_LDB(B1, 0, 1); PG8_SCHED; PG8_LDA(At, 0, 0); PG8_STAGE(PG8_SA(1, 1), a1 + hstepA, voffA);
            PG8_WAIT_V(8); PG8_WAIT_L(0); PG8_BAR; PG8_MMA(0, 0, At, B0); PG8_MMA(0, 1, At, B1); PG8_BAR; PG8_SCHED;
            PG8_LDA(At, 0, 1); PG8_STAGE(PG8_SB(0, 0), b2, voffB); PG8_STAGE(PG8_SB(0, 1), b2 + hstepB, voffB); PG8_STAGE(PG8_SA(0, 0), a2, voffA);
            PG8_WAIT_V(8); PG8_WAIT_L(0); PG8_BAR; PG8_MMA(1, 0, At, B0); PG8_MMA(1, 1, At, B1); PG8_BAR; PG8_SCHED;
            PG8_LDB(B0, 1, 0); PG8_LDB(B1, 1, 1); PG8_SCHED; PG8_LDA(At, 1, 0); PG8_STAGE(PG8_SA(0, 1), a2 + hstepA, voffA);
            PG8_WAIT_V(8); PG8_WAIT_L(0); PG8_BAR; PG8_MMA(0, 0, At, B0); PG8_MMA(0, 1, At, B1); PG8_BAR; PG8_SCHED;
            PG8_LDA(At, 1, 1); PG8_STAGE(PG8_SB(1, 0), b3, voffB); PG8_STAGE(PG8_SB(1, 1), b3 + hstepB, voffB); PG8_STAGE(PG8_SA(1, 0), a3, voffA);
            PG8_WAIT_V(8); PG8_WAIT_L(0); PG8_BAR; PG8_MMA(1, 0, At, B0); PG8_MMA(1, 1, At, B1); PG8_BAR; PG8_SCHED;
            } else {
            PG8_LDB(B0, 0, 0); PG8_SCHED; PG8_LDA(At, 0, 0); PG8_STAGE(PG8_SA(1, 1), a1 + hstepA, voffA);
            PG8_WAIT_L(8); PG8_BAR; PG8_WAIT_L(0); PG8_MMA(0, 0, At, B0); PG8_BAR; PG8_SCHED;
            PG8_LDB(B1, 0, 1); PG8_STAGE(PG8_SB(0, 0), b2, voffB);
            PG8_BAR; PG8_WAIT_L(0); PG8_MMA(0, 1, At, B1); PG8_BAR;
            PG8_LDA(At, 0, 1); PG8_STAGE(PG8_SA(0, 0), a2, voffA);
            PG8_BAR; PG8_WAIT_L(0); PG8_MMA(1, 0, At, B0); PG8_BAR; PG8_SCHED;
            PG8_STAGE(PG8_SB(0, 1), b2 + hstepB, voffB);
            PG8_WAIT_V(6); PG8_BAR; PG8_MMA(1, 1, At, B1); PG8_BAR;
            PG8_LDB(B0, 1, 0); PG8_SCHED; PG8_LDA(At, 1, 0); PG8_STAGE(PG8_SA(0, 1), a2 + hstepA, voffA);
            PG8_WAIT_L(8); PG8_BAR; PG8_WAIT_L(0); PG8_MMA(0, 0, At, B0); PG8_BAR; PG8_SCHED;
            PG8_LDB(B1, 1, 1); PG8_STAGE(PG8_SB(1, 0), b3, voffB);
            PG8_BAR; PG8_WAIT_L(0); PG8_MMA(0, 1, At, B1); PG8_BAR;
            PG8_LDA(At, 1, 1); PG8_STAGE(PG8_SA(1, 0), a3, voffA);
            PG8_BAR; PG8_WAIT_L(0); PG8_MMA(1, 0, At, B0); PG8_BAR; PG8_SCHED;
            PG8_STAGE(PG8_SB(1, 1), b3 + hstepB, voffB);
            PG8_WAIT_V(6); PG8_BAR; PG8_MMA(1, 1, At, B1); PG8_BAR;
            }
        }
        if constexpr (ALIGN_EPI) { if (wr == 0) PG8_BAR; }
        if constexpr (!Epi::AFTER_DRAIN) { E(acc, cur, wr, wc, fr, fq); S.done(cur); }
        if (!has_next) break;
#pragma unroll
        for (int a = 0; a < 2; ++a)
#pragma unroll
            for (int b = 0; b < 2; ++b)
#pragma unroll
                for (int m = 0; m < 4; ++m)
#pragma unroll
                    for (int n = 0; n < 2; ++n) acc[a][b][m][n] = (f32x4){0.f, 0.f, 0.f, 0.f};
        cur = nxt; cA = nA; cB = nB; ++ui;
        if constexpr (ALIGN_EPI) { if (wr == 1) PG8_BAR; }
    }
    PG8_WAIT_V(0);
    if constexpr (!ALIGN_EPI) { if (wr == 0) PG8_BAR; }
    PG8_BAR;
    if constexpr (Epi::AFTER_DRAIN) { E.fused(acc, cur, wr, wc, fr, fq, lds, wid, lane); S.done(cur); }
#undef PG8_SA
#undef PG8_SB
#undef PG8_STAGE
#undef PG8_LDA
#undef PG8_LDB
#undef PG8_MMA
#undef PG8_WAIT_V
#undef PG8_WAIT_L
#undef PG8_BAR
#undef PG8_SCHED
}

template <class Epi, class Sched>
__device__ __forceinline__ void gemm_naive(const Gemm g, const Sched& S, const Epi& E) {
    int tid_ = threadIdx.x; asm volatile("" : "+v"(tid_));
    const int tid = tid_, wid = __builtin_amdgcn_readfirstlane(tid >> 6), lane = tid & 63, wr = wid >> 2, wc = wid & 3, fr = lane & 15, fq = lane >> 4;
    Unit u;
    for (int ui = 0; S.next(ui, u); ++ui) {
        f32x4 acc[2][2][4][2];
#pragma unroll
        for (int a = 0; a < 2; ++a)
#pragma unroll
            for (int b = 0; b < 2; ++b)
#pragma unroll
                for (int m = 0; m < 4; ++m)
#pragma unroll
                    for (int n = 0; n < 2; ++n) acc[a][b][m][n] = (f32x4){0.f, 0.f, 0.f, 0.f};
        for (int k0 = 0; k0 < g.K; k0 += 8) {
            float af[2][4][8];
#pragma unroll
            for (int ai = 0; ai < 2; ++ai)
#pragma unroll
                for (int m = 0; m < 4; ++m) { const u32x4 v = *(const u32x4*)(g.A + (size_t)(u.pm * 256 + ai * 128 + wr * 64 + m * 16 + fr) * g.lda + k0);
                    af[ai][m][0] = bflo(v.x); af[ai][m][1] = bfhi(v.x); af[ai][m][2] = bflo(v.y); af[ai][m][3] = bfhi(v.y); af[ai][m][4] = bflo(v.z); af[ai][m][5] = bfhi(v.z); af[ai][m][6] = bflo(v.w); af[ai][m][7] = bfhi(v.w); }
#pragma unroll
            for (int bj = 0; bj < 2; ++bj)
#pragma unroll
                for (int n = 0; n < 2; ++n)
#pragma unroll
                    for (int j = 0; j < 4; ++j) {
                        const int col = u.pn * 256 + bj * 128 + wc * 32 + (Epi::PERM ? (8 * fq + 4 * n + j) : (16 * n + 4 * fq + j));
                        const u32x4 v = *(const u32x4*)(g.Bt + (size_t)col * g.K + k0);
                        const float b0 = bflo(v.x), b1 = bfhi(v.x), b2 = bflo(v.y), b3 = bfhi(v.y), b4 = bflo(v.z), b5 = bfhi(v.z), b6 = bflo(v.w), b7 = bfhi(v.w);
#pragma unroll
                        for (int ai = 0; ai < 2; ++ai)
#pragma unroll
                            for (int m = 0; m < 4; ++m) {
                                const float* a = af[ai][m];
                                acc[ai][bj][m][n][j] += ((a[0] * b0 + a[1] * b1) + (a[2] * b2 + a[3] * b3)) + ((a[4] * b4 + a[5] * b5) + (a[6] * b6 + a[7] * b7));
                            }
                    }
        }
        E(acc, u, wr, wc, fr, fq);
    }
}
}
using pg8::Unit;
typedef const f32x4 (&AccRef)[2][2][4][2];
__device__ __forceinline__ void load_rstd(float (&rs)[2][4], const float* stats, const Unit& u, int wr, int fr, int fq) {
#pragma unroll
    for (int ai = 0; ai < 2; ++ai)
#pragma unroll
        for (int m = 0; m < 4; ++m) {
            const int row = u.pm * 256 + ai * 128 + wr * 64 + m * 16 + fr;
            const f32x4 v = *(const GAS f32x4*)(stats + (size_t)row * 16 + 4 * fq);
            float s = (v.x + v.y) + (v.z + v.w); s += __shfl_xor(s, 16); s += __shfl_xor(s, 32);
            rs[ai][m] = rsqrtf(s * (1.0f / DM) + EPS);
        }
}
__device__ __forceinline__ u32x4 pack8(const f32x4 a, const f32x4 b) { u32x4 w; w.x = cvt_pk(a[0], a[1]); w.y = cvt_pk(a[2], a[3]); w.z = cvt_pk(b[0], b[1]); w.w = cvt_pk(b[2], b[3]); return w; }

struct EpiSwiglu {
    static constexpr bool PERM = true, AFTER_DRAIN = false;
    bf16_t* out; const float* stats;
    __device__ __forceinline__ void operator()(AccRef acc, const Unit& u, int wr, int wc, int fr, int fq) const {
        float rs[2][4]; load_rstd(rs, stats, u, wr, fr, fq);
#pragma unroll
        for (int ai = 0; ai < 2; ++ai)
#pragma unroll
            for (int m = 0; m < 4; ++m) { asm volatile("" ::: "memory");
                const int row = u.pm * 256 + ai * 128 + wr * 64 + m * 16 + fr; const float r = rs[ai][m];
                const float r2 = -r * LOG2E, rr = r * r;
                f32x4 o[2];
#pragma unroll
                for (int n = 0; n < 2; ++n)
#pragma unroll
                    for (int j = 0; j < 4; ++j) { const float a = acc[ai][0][m][n][j], b = acc[ai][1][m][n][j];
                        o[n][j] = (a * b) * (rr * __builtin_amdgcn_rcpf(1.0f + __builtin_amdgcn_exp2f(a * r2))); }
                *(GAS u32x4*)(out + (size_t)row * FF + u.pn * 128 + wc * 32 + 8 * fq) = pack8(o[0], o[1]);
            }
    }
};
template <bool GATE> struct EpiResid {
    static constexpr bool PERM = true, AFTER_DRAIN = false;
    const bf16_t* res; bf16_t* hb; float* stats_out; float alpha; const float* stats_in; const bf16_t* pe;
    __device__ __forceinline__ void operator()(AccRef acc, const Unit& u, int wr, int wc, int fr, int fq) const {
        float rs[2][4];
        if (GATE) load_rstd(rs, stats_in, u, wr, fr, fq);
        constexpr int MB = GATE ? 1 : 2;
#pragma unroll
        for (int ag = 0; ag < 8 / MB; ++ag) { const int ai = (ag * MB) >> 2, m0 = (ag * MB) & 3;
            u32x4 rw[4][2], pw[4][2];
            asm volatile("" ::: "memory");
#pragma unroll
            for (int m = m0; m < m0 + MB; ++m)
#pragma unroll
                for (int bj = 0; bj < 2; ++bj) {
                    const size_t off = (size_t)(u.pm * 256 + ai * 128 + wr * 64 + m * 16 + fr) * DM + u.pn * 256 + bj * 128 + wc * 32 + 8 * fq;
                    rw[m][bj] = *(const GAS u32x4*)(res + off);
                    if (GATE) pw[m][bj] = *(const GAS u32x4*)(pe + off);
                }
            asm volatile("" ::: "memory");
#pragma unroll
            for (int m = m0; m < m0 + MB; ++m) {
                const int row = u.pm * 256 + ai * 128 + wr * 64 + m * 16 + fr; float ss = 0.f;
#pragma unroll
                for (int bj = 0; bj < 2; ++bj) {
                    const size_t off = (size_t)row * DM + u.pn * 256 + bj * 128 + wc * 32 + 8 * fq;
                    f32x4 v0 = acc[ai][bj][m][0], v1 = acc[ai][bj][m][1];
                    if (GATE) { const u32x4 p = pw[m][bj]; const float r = rs[ai][m];
                        v0[0] = fsigmoid(v0[0] * r) * bflo(p.x); v0[1] = fsigmoid(v0[1] * r) * bfhi(p.x); v0[2] = fsigmoid(v0[2] * r) * bflo(p.y); v0[3] = fsigmoid(v0[3] * r) * bfhi(p.y);
                        v1[0] = fsigmoid(v1[0] * r) * bflo(p.z); v1[1] = fsigmoid(v1[1] * r) * bfhi(p.z); v1[2] = fsigmoid(v1[2] * r) * bflo(p.w); v1[3] = fsigmoid(v1[3] * r) * bfhi(p.w); }
                    const u32x4 w = rw[m][bj];
                    const f32x4 r0 = (f32x4){bflo(w.x), bfhi(w.x), bflo(w.y), bfhi(w.y)}, r1 = (f32x4){bflo(w.z), bfhi(w.z), bflo(w.w), bfhi(w.w)};
                    const f32x4 h0 = r0 + alpha * v0, h1 = r1 + alpha * v1;
                    *(GAS u32x4*)(hb + off) = pack8(h0, h1);
                    ss += (h0[0] * h0[0] + h0[1] * h0[1]) + (h0[2] * h0[2] + h0[3] * h0[3]) + (h1[0] * h1[0] + h1[1] * h1[1]) + (h1[2] * h1[2] + h1[3] * h1[3]);
                }
                ss += __shfl_xor(ss, 16); ss += __shfl_xor(ss, 32);
                if (fq == 0) ((GAS float*)stats_out)[(size_t)row * 16 + u.pn * 4 + wc] = ss;
            }
        }
    }
};
struct EpiInproj {
    static constexpr bool PERM = true, AFTER_DRAIN = false;
    bf16_t* zA; bf16_t* qB; const float* stats;
    __device__ __forceinline__ void operator()(AccRef acc, const Unit& u, int wr, int wc, int fr, int fq) const {
        float rs[2][4]; load_rstd(rs, stats, u, wr, fr, fq);
        bf16_t* base; int pitch;
        if (u.pn < 3) { base = zA + 256 * u.pn; pitch = 768; } else { const int k = (u.pn - 3) >> 1; base = qB + (size_t)k * (16 * MiB / 2) + 256 * ((u.pn - 3) & 1); pitch = 512; }
#pragma unroll
        for (int ai = 0; ai < 2; ++ai)
#pragma unroll
            for (int m = 0; m < 4; ++m) { asm volatile("" ::: "memory");
                const int row = u.pm * 256 + ai * 128 + wr * 64 + m * 16 + fr; const float r = rs[ai][m];
#pragma unroll
                for (int bj = 0; bj < 2; ++bj) *(GAS u32x4*)(base + (size_t)row * pitch + bj * 128 + wc * 32 + 8 * fq) = pack8(acc[ai][bj][m][0] * r, acc[ai][bj][m][1] * r);
            }
    }
};
struct EpiGates {
    static constexpr bool PERM = true, AFTER_DRAIN = false;
    bf16_t* X; const float* stats;
    __device__ __forceinline__ void operator()(AccRef acc, const Unit& u, int wr, int wc, int fr, int fq) const {
        float rs[2][4]; load_rstd(rs, stats, u, wr, fr, fq);
#pragma unroll
        for (int ai = 0; ai < 2; ++ai)
#pragma unroll
            for (int m = 0; m < 4; ++m) { asm volatile("" ::: "memory");
                const int row = u.pm * 256 + ai * 128 + wr * 64 + m * 16 + fr; const float r2 = -rs[ai][m] * LOG2E;
#pragma unroll
                for (int bj = 0; bj < 2; ++bj) { f32x4 a = acc[ai][bj][m][0], b = acc[ai][bj][m][1];
#pragma unroll
                    for (int j = 0; j < 4; ++j) { a[j] = __builtin_amdgcn_rcpf(1.0f + __builtin_amdgcn_exp2f(a[j] * r2)); b[j] = __builtin_amdgcn_rcpf(1.0f + __builtin_amdgcn_exp2f(b[j] * r2)); }
                    *(GAS u32x4*)(X + (size_t)row * 3072 + u.pn * 256 + bj * 128 + wc * 32 + 8 * fq) = pack8(a, b); }
            }
    }
};
struct EpiMulGate {
    static constexpr bool PERM = true, AFTER_DRAIN = false;
    bf16_t* X; int br;
    __device__ __forceinline__ void operator()(AccRef acc, const Unit& u, int wr, int wc, int fr, int fq) const {
#pragma unroll
        for (int ai = 0; ai < 2; ++ai)
#pragma unroll
            for (int m = 0; m < 4; ++m) { asm volatile("" ::: "memory");
                const int row = u.pm * 256 + ai * 128 + wr * 64 + m * 16 + fr;
#pragma unroll
                for (int bj = 0; bj < 2; ++bj) { bf16_t* p = X + (size_t)row * 3072 + br * 1024 + u.pn * 256 + bj * 128 + wc * 32 + 8 * fq;
                    const u32x4 g = *(const GAS u32x4*)p; f32x4 a = acc[ai][bj][m][0], b = acc[ai][bj][m][1];
                    a[0] *= bflo(g.x); a[1] *= bfhi(g.x); a[2] *= bflo(g.y); a[3] *= bfhi(g.y); b[0] *= bflo(g.z); b[1] *= bfhi(g.z); b[2] *= bflo(g.w); b[3] *= bfhi(g.w);
                    *(GAS u32x4*)p = pack8(a, b); }
            }
    }
};
struct EpiStore {
    static constexpr bool PERM = true, AFTER_DRAIN = false;
    bf16_t* out; int pitch; const float* rowscale;
    __device__ __forceinline__ void operator()(AccRef acc, const Unit& u, int wr, int wc, int fr, int fq) const {
#pragma unroll
        for (int ai = 0; ai < 2; ++ai)
#pragma unroll
            for (int m = 0; m < 4; ++m) { asm volatile("" ::: "memory");
                const int row = u.pm * 256 + ai * 128 + wr * 64 + m * 16 + fr; const float r = rowscale ? ((const GAS float*)rowscale)[2 * (size_t)row] : 1.0f;
#pragma unroll
                for (int bj = 0; bj < 2; ++bj) *(GAS u32x4*)(out + (size_t)row * pitch + u.pn * 256 + bj * 128 + wc * 32 + 8 * fq) = pack8(acc[ai][bj][m][0] * r, acc[ai][bj][m][1] * r);
            }
    }
};
struct EpiMulGateAcc {
    static constexpr bool PERM = true, AFTER_DRAIN = false;
    const bf16_t* X; bf16_t* Xm; int br;
    __device__ __forceinline__ void operator()(AccRef acc, const Unit& u, int wr, int wc, int fr, int fq) const {
#pragma unroll
        for (int ag = 0; ag < 4; ++ag) { const int ai = ag >> 1, m0 = 2 * (ag & 1);
            u32x4 gw[4][2], qw[4][2];
            asm volatile("" ::: "memory");
#pragma unroll
            for (int m = m0; m < m0 + 2; ++m)
#pragma unroll
                for (int bj = 0; bj < 2; ++bj) {
                    const int row = u.pm * 256 + ai * 128 + wr * 64 + m * 16 + fr, col = u.pn * 256 + bj * 128 + wc * 32 + 8 * fq;
                    gw[m][bj] = *(const GAS u32x4*)(X + (size_t)row * 3072 + br * 1024 + col);
                    qw[m][bj] = (br > 0) ? *(const GAS u32x4*)(Xm + (size_t)row * DM + col) : (u32x4){0u, 0u, 0u, 0u};
                }
            asm volatile("" ::: "memory");
#pragma unroll
            for (int m = m0; m < m0 + 2; ++m) {
                const int row = u.pm * 256 + ai * 128 + wr * 64 + m * 16 + fr;
#pragma unroll
                for (int bj = 0; bj < 2; ++bj) { const int col = u.pn * 256 + bj * 128 + wc * 32 + 8 * fq;
                    const u32x4 g = gw[m][bj], q = qw[m][bj];
                    f32x4 a = acc[ai][bj][m][0], b = acc[ai][bj][m][1];
                    a[0] = a[0] * bflo(g.x) + bflo(q.x); a[1] = a[1] * bfhi(g.x) + bfhi(q.x); a[2] = a[2] * bflo(g.y) + bflo(q.y); a[3] = a[3] * bfhi(g.y) + bfhi(q.y);
                    b[0] = b[0] * bflo(g.z) + bflo(q.z); b[1] = b[1] * bfhi(g.z) + bfhi(q.z); b[2] = b[2] * bflo(g.w) + bflo(q.w); b[3] = b[3] * bfhi(g.w) + bfhi(q.w);
                    *(GAS u32x4*)(Xm + (size_t)row * DM + col) = pack8(a, b); }
            }
        }
    }
};
struct WSP {
    unsigned* ctl; f32x2* rope; float* stats0; float* stats1; float* statq; bf16_t* WB;
    bf16_t *HB, *HB2, *PBF, *zA, *qM, *qB, *qC, *kB, *vB, *kC, *vC, *kvM, *X, *FFH, *PE, *Xm;
};
template <int MODE> struct ACfg;
template <> struct ACfg<0> { static constexpr int DQK = 96, DV = 64, KP = 208, VP = 192; };
template <> struct ACfg<1> { static constexpr int DQK = 64, DV = 128, KP = 144, VP = 320; };
template <> struct ACfg<2> { static constexpr int DQK = 64, DV = 64, KP = 144, VP = 192; };
constexpr int A_KOFF = 0, A_VOFF = 32768, A_FLAG = 73728, A_IDX = 73728 + 64, A_XCH = 73728 + 128;
__device__ __forceinline__ int crow(int r, int hi) { return (r & 3) + 8 * (r >> 2) + 4 * hi; }
__device__ __forceinline__ float pmax32(float v) { const auto rr = __builtin_amdgcn_permlane32_swap(__float_as_uint(v), __float_as_uint(v), false, false); return fmaxf(__uint_as_float(rr[0]), __uint_as_float(rr[1])); }
__device__ __forceinline__ float psum32(float v) { const auto rr = __builtin_amdgcn_permlane32_swap(__float_as_uint(v), __float_as_uint(v), false, false); return __uint_as_float(rr[0]) + __uint_as_float(rr[1]); }
__device__ __forceinline__ float diff_lambda(const float* const* in, int layer) {
    const float* q1 = in[12] + layer * 64; const float* k1 = in[13] + layer * 64; const float* q2 = in[14] + layer * 64; const float* k2 = in[15] + layer * 64;
    float s1 = 0.f, s2 = 0.f;
    for (int i = 0; i < 64; ++i) { s1 += q1[i] * k1[i]; s2 += q2[i] * k2[i]; }
    const float li = layer == 0 ? 0.2f : 0.35550906759f;
    return expf(s1) - expf(s2) + li;
}

template <int MODE>
__device__ __forceinline__ void attn_unit(const WSP& W, const float* const* in, int layer, int b, int h, int qb, LAS unsigned char* lds) {
    using C = ACfg<MODE>;
    constexpr int DQK = C::DQK, DV = C::DV, KP = C::KP, VP = C::VP, NS = DQK / 16, ND = DV / 32, CHK = DQK / 8, CHV = DV / 8;
    constexpr int KBUF = 64 * KP, VBUF = 64 * VP;
    int tid_ = threadIdx.x; asm volatile("" : "+v"(tid_));
    const int tid = tid_, lane = tid & 63, wid = __builtin_amdgcn_readfirstlane(tid >> 6), r32 = lane & 31, hi = lane >> 5;
    const size_t rowbase = (size_t)b * SEQ; const int q0 = qb * 256, NT = 4 * (qb + 1);
    const int qpos = q0 + wid * 32 + r32;
    const int wq_lo = q0 + wid * 32, wq_hi = wq_lo + 31;
    constexpr int NPASS = (MODE == 1) ? 2 : 1;
    unsigned osave[ND][8];
    float slope2 = 0.f;
    if (MODE == 1) slope2 = exp2f(-2.0f * (float)(h + 1)) * LOG2E;
    const int koff = r32 * KP + hi * 16;
    const int voff = (4 * hi + ((lane & 15) >> 2)) * VP + (((lane >> 4) & 1) * 16 + (lane & 3) * 4) * 2;
    f32x16 o[ND];
    float l_run = 0.f;
#pragma unroll 1
    for (int pass = 0; pass < NPASS; ++pass) {
        const bf16_t *Qrow, *K1, *K2 = nullptr, *V; int k1p, k2p = 0, vp;
        if (MODE == 0) { Qrow = W.qM + (rowbase + qpos) * 768; K1 = W.kvM + rowbase * 1024 + 64 * h; k1p = 1024; K2 = W.zA + rowbase * 768 + 384; k2p = 768; V = W.kvM + rowbase * 1024 + 512 + 64 * h; vp = 1024; }
        else if (MODE == 1) { Qrow = W.qB + (rowbase + qpos) * 512 + 128 * h + 64 * pass; K1 = W.kB + rowbase * 512 + 128 * h + 64 * pass; k1p = 512; V = W.vB + rowbase * 512 + 128 * h; vp = 512; }
        else { Qrow = W.qC + (rowbase + qpos) * 512 + 64 * h; K1 = W.kC + rowbase * 512 + 64 * h; k1p = 512; V = W.vC + rowbase * 512 + 64 * h; vp = 512; }
        bf16x8 qf[NS];
#pragma unroll
        for (int s = 0; s < NS; ++s) {
            if (MODE == 0) qf[s] = (s < 4) ? *(const GAS bf16x8*)(Qrow + 64 * h + 16 * s + 8 * hi) : *(const GAS bf16x8*)(Qrow + 512 + 32 * h + 16 * (s - 4) + 8 * hi);
            else qf[s] = *(const GAS bf16x8*)(Qrow + 16 * s + 8 * hi);
        }
        if (MODE == 0) {
            const GAS f32x4* tp = (const GAS f32x4*)(W.rope + (size_t)qpos * 16 + 8 * hi);
            u32x4 a = __builtin_bit_cast(u32x4, qf[NS - 2]), c = __builtin_bit_cast(u32x4, qf[NS - 1]);
#pragma unroll
            for (int i = 0; i < 4; ++i) { const f32x4 cs = tp[i];
                const float x1l = bflo(a[i]), x1h = bfhi(a[i]), x2l = bflo(c[i]), x2h = bfhi(c[i]);
                a[i] = cvt_pk(x1l * cs[0] - x2l * cs[1], x1h * cs[2] - x2h * cs[3]); c[i] = cvt_pk(x2l * cs[0] + x1l * cs[1], x2h * cs[2] + x1h * cs[3]); }
            qf[NS - 2] = __builtin_bit_cast(bf16x8, a); qf[NS - 1] = __builtin_bit_cast(bf16x8, c);
        }
#pragma unroll
        for (int d = 0; d < ND; ++d) o[d] = (f32x16){};
        float m_run = -1e30f; l_run = 0.f;
        float carry = 1.0f;
        u32x4 kst[2], vst[2], kst2[2], vst2[2];
        const int kkey0 = tid / CHK, kch0 = tid % CHK, kkey1 = (tid + 512) / CHK, kch1 = (tid + 512) % CHK;
        const int vkey0 = tid / CHV, vch0 = tid % CHV, vkey1 = (tid + 512) / CHV, vch1 = (tid + 512) % CHV;
        constexpr bool K2ND = (64 * CHK > 512), V2ND = (64 * CHV > 512);
        const bool k2nd = K2ND && (tid + 512 < 64 * CHK);
#define ATT_KSRC(key, ch) ((MODE == 0 && (ch) >= 8) ? (K2 + (size_t)(key) * k2p + 8 * ((ch) - 8)) : (K1 + (size_t)(key) * k1p + 8 * (ch)))
#define ATT_LOAD(kt_) do { const int key0_ = 64 * (kt_); \
            kst[0] = *(const GAS u32x4*)ATT_KSRC(key0_ + kkey0, kch0); if (k2nd) kst[1] = *(const GAS u32x4*)ATT_KSRC(key0_ + kkey1, kch1); \
            vst[0] = *(const GAS u32x4*)(V + (size_t)(key0_ + vkey0) * vp + 8 * vch0); if (V2ND) vst[1] = *(const GAS u32x4*)(V + (size_t)(key0_ + vkey1) * vp + 8 * vch1); } while (0)
#define ATT_LOAD2(kt_) do { const int key0_ = 64 * (kt_); \
            kst2[0] = *(const GAS u32x4*)ATT_KSRC(key0_ + kkey0, kch0); if (k2nd) kst2[1] = *(const GAS u32x4*)ATT_KSRC(key0_ + kkey1, kch1); \
            vst2[0] = *(const GAS u32x4*)(V + (size_t)(key0_ + vkey0) * vp + 8 * vch0); if (V2ND) vst2[1] = *(const GAS u32x4*)(V + (size_t)(key0_ + vkey1) * vp + 8 * vch1); } while (0)
#define ATT_STORE(buf_) do { LAS unsigned char* kb_ = lds + A_KOFF + (buf_) * KBUF; LAS unsigned char* vb_ = lds + A_VOFF + (buf_) * VBUF; \
            *(LAS u32x4*)(kb_ + kkey0 * KP + kch0 * 16) = kst[0]; if (k2nd) *(LAS u32x4*)(kb_ + kkey1 * KP + kch1 * 16) = kst[1]; \
            *(LAS u32x4*)(vb_ + vkey0 * VP + vch0 * 16) = vst[0]; if (V2ND) *(LAS u32x4*)(vb_ + vkey1 * VP + vch1 * 16) = vst[1]; } while (0)
        __syncthreads();
        ATT_LOAD(MODE == 2 ? NT - 1 : 0); ATT_STORE(0);
        constexpr bool DEFER = (MODE != 1);
        if (DEFER) ATT_LOAD(MODE == 2 ? NT - 2 : 1);
        __syncthreads();
#pragma unroll 1
        for (int t = 0; t < NT; ++t) {
            const int kt = (MODE == 2) ? (NT - 1 - t) : t;
            const bool more = (t + 1 < NT);
            if (DEFER) { if (t + 2 < NT) ATT_LOAD2(MODE == 2 ? kt - 2 : kt + 2); } else { if (more) ATT_LOAD(MODE == 2 ? kt - 1 : kt + 1); }
            const int key0 = 64 * kt;
            const bool band = (kt >= NT - 4);
            bool active = (key0 <= wq_hi);
            bool alive = true;
            if (MODE == 2) { alive = __any(carry != 0.0f); active = active && alive; }
            if (active) {
                LAS unsigned char* kb = lds + A_KOFF + (t & 1) * KBUF + koff;
                LAS unsigned char* vb = lds + A_VOFF + (t & 1) * VBUF + voff;
                f32x16 s0, s1;
                if (MODE == 1) {
                    const float t1 = slope2 * (float)(key0 + 4 * hi - qpos);
#pragma unroll
                    for (int r = 0; r < 16; ++r) { const float c = (float)((r & 3) + 8 * (r >> 2)); s0[r] = fmaf(slope2, c, t1); s1[r] = fmaf(slope2, c + 32.0f, t1); }
                } else { s0 = (f32x16){}; s1 = (f32x16){}; }
#pragma unroll
                for (int s = 0; s < NS; ++s) {
                    const bf16x8 k0 = *(const LAS bf16x8*)(kb + s * 32), k1 = *(const LAS bf16x8*)(kb + 32 * KP + s * 32);
                    s0 = __builtin_amdgcn_mfma_f32_32x32x16_bf16(k0, qf[s], s0, 0, 0, 0);
                    s1 = __builtin_amdgcn_mfma_f32_32x32x16_bf16(k1, qf[s], s1, 0, 0, 0);
                }
                if (MODE != 2) {
                    if (band) {
                        asm volatile("" ::: "memory");
#pragma unroll
                        for (int r = 0; r < 16; ++r) { const int key = key0 + crow(r, hi); if (key > qpos) s0[r] = -INFINITY; if (key + 32 > qpos) s1[r] = -INFINITY; }
                    }
                    float mx = fmaxf(s0[0], s1[0]);
#pragma unroll
                    for (int r = 1; r < 16; ++r) mx = fmaxf(mx, fmaxf(s0[r], s1[r]));
                    mx = pmax32(mx);
                    const float m_new = fmaxf(m_run, mx);
                    const float alpha = __builtin_amdgcn_exp2f(m_run - m_new);
                    m_run = m_new;
                    float ps = 0.f;
#pragma unroll
                    for (int r = 0; r < 16; ++r) { s0[r] = __builtin_amdgcn_exp2f(s0[r] - m_new); s1[r] = __builtin_amdgcn_exp2f(s1[r] - m_new); ps += s0[r] + s1[r]; }
                    l_run = l_run * alpha + ps;
#pragma unroll
                    for (int d = 0; d < ND; ++d) o[d] *= alpha;
                } else {
#pragma unroll
                    for (int r = 0; r < 16; ++r) {
                        float e0 = __builtin_amdgcn_exp2f(s0[r]), e1 = __builtin_amdgcn_exp2f(s1[r]);
                        float m0 = __builtin_amdgcn_rcpf(1.0f + e0), m1 = __builtin_amdgcn_rcpf(1.0f + e1);
                        s0[r] = m0; s1[r] = m1;
                    }
                    if (band) {
                        asm volatile("" ::: "memory");
#pragma unroll
                        for (int r = 0; r < 16; ++r) { const int key = key0 + crow(r, hi); if (key >= qpos) s0[r] = 1.0f; if (key + 32 >= qpos) s1[r] = 1.0f; }
                    }
                    float gp[8];
#pragma unroll
                    for (int a = 0; a < 8; ++a) {
                        const int rb = 4 * (a & 3);
                        float x0, x1, x2, x3;
                        if (a < 4) { x0 = s0[rb]; x1 = s0[rb + 1]; x2 = s0[rb + 2]; x3 = s0[rb + 3]; } else { x0 = s1[rb]; x1 = s1[rb + 1]; x2 = s1[rb + 2]; x3 = s1[rb + 3]; }
                        const float e2 = x3, e1 = e2 * x2, e0 = e1 * x1;
                        gp[a] = e0 * x0;
                        const float w3 = (1.0f - x3), w2 = (1.0f - x2) * e2, w1 = (1.0f - x1) * e1, w0 = (1.0f - x0) * e0;
                        if (a < 4) { s0[rb] = w0; s0[rb + 1] = w1; s0[rb + 2] = w2; s0[rb + 3] = w3; } else { s1[rb] = w0; s1[rb + 1] = w1; s1[rb + 2] = w2; s1[rb + 3] = w3; }
                    }
                    float f = carry;
#pragma unroll
                    for (int a = 7; a >= 0; --a) {
                        const int rb = 4 * (a & 3);
                        const auto rr_ = __builtin_amdgcn_permlane32_swap(__float_as_uint(gp[a]), __float_as_uint(gp[a]), false, false);
                        const float g_lo = __uint_as_float(rr_[0]), g_hi = __uint_as_float(rr_[1]);
                        const float fac = (hi == 0) ? f * g_hi : f;
                        if (a < 4) { s0[rb] *= fac; s0[rb + 1] *= fac; s0[rb + 2] *= fac; s0[rb + 3] *= fac; } else { s1[rb] *= fac; s1[rb + 1] *= fac; s1[rb + 2] *= fac; s1[rb + 3] *= fac; }
                        f *= g_lo * g_hi;
                    }
                    carry = f;
                }
#pragma unroll
                for (int g = 0; g < 4; ++g) {
                    const int rb = 8 * (g & 1);
                    u32x4 pw;
                    if (g < 2) { pw.x = cvt_pk(s0[rb], s0[rb + 1]); pw.y = cvt_pk(s0[rb + 2], s0[rb + 3]); pw.z = cvt_pk(s0[rb + 4], s0[rb + 5]); pw.w = cvt_pk(s0[rb + 6], s0[rb + 7]); }
                    else { pw.x = cvt_pk(s1[rb], s1[rb + 1]); pw.y = cvt_pk(s1[rb + 2], s1[rb + 3]); pw.z = cvt_pk(s1[rb + 4], s1[rb + 5]); pw.w = cvt_pk(s1[rb + 6], s1[rb + 7]); }
                    const bf16x8 pf = __builtin_bit_cast(bf16x8, pw);
#pragma unroll
                    for (int d = 0; d < ND; ++d) {
                        const v4i16_t lo = __builtin_amdgcn_ds_read_tr16_b64_v4i16((LAS v4i16_t*)(vb + g * 16 * VP + d * 64));
                        const v4i16_t hh = __builtin_amdgcn_ds_read_tr16_b64_v4i16((LAS v4i16_t*)(vb + g * 16 * VP + 8 * VP + d * 64));
                        const bf16x8 vf = (bf16x8){lo[0], lo[1], lo[2], lo[3], hh[0], hh[1], hh[2], hh[3]};
                        o[d] = __builtin_amdgcn_mfma_f32_32x32x16_bf16(vf, pf, o[d], 0, 0, 0);
                    }
                }
            }
            if (MODE == 2) { const bool alive2 = alive && __any(carry != 0.0f); if (lane == 0) *(volatile LAS unsigned*)(lds + A_FLAG + ((t & 1) * 8 + wid) * 4) = alive2 ? 1u : 0u; }
            if (more) ATT_STORE((t + 1) & 1);
            if (DEFER) { kst[0] = kst2[0]; kst[1] = kst2[1]; vst[0] = vst2[0]; vst[1] = vst2[1]; }
            __syncthreads();
            if (MODE == 2) {
                unsigned any = 0;
#pragma unroll
                for (int w = 0; w < 8; ++w) any |= *(volatile LAS unsigned*)(lds + A_FLAG + ((t & 1) * 8 + w) * 4);
                if (any == 0) break;
            }
        }
#undef ATT_KSRC
#undef ATT_LOAD
#undef ATT_LOAD2
#undef ATT_STORE
        if (MODE == 1 && pass == 0) {
            const float inv = 1.0f / psum32(l_run);
#pragma unroll
            for (int d = 0; d < ND; ++d)
#pragma unroll
                for (int r = 0; r < 8; ++r) osave[d][r] = cvt_pk(o[d][2 * r] * inv, o[d][2 * r + 1] * inv);
        }
    }
    bf16_t* Orow;
    if (MODE == 0) Orow = W.qM + (rowbase + qpos) * 768 + 64 * h;
    else if (MODE == 1) Orow = W.qB + (rowbase + qpos) * 512 + 128 * h;
    else Orow = W.qC + (rowbase + qpos) * 512 + 64 * h;
    if (MODE == 0) {
        const float inv = 1.0f / psum32(l_run);
#pragma unroll
        for (int d = 0; d < ND; ++d) o[d] *= inv;
    } else if (MODE == 1) {
        const float lam = diff_lambda(in, layer);
        const float inv = 1.0f / psum32(l_run);
        float ss = 0.f;
#pragma unroll
        for (int d = 0; d < ND; ++d)
#pragma unroll
            for (int r = 0; r < 16; ++r) { const float y = ((r & 1) ? bfhi(osave[d][r >> 1]) : bflo(osave[d][r >> 1])) - lam * (o[d][r] * inv); o[d][r] = y; ss += y * y; }
        ss = psum32(ss);
        const float li = layer == 0 ? 0.2f : 0.35550906759f;
        const float rs = rsqrtf(ss * (1.0f / 128.0f) + EPS) * (1.0f - li);
        const float* gs = in[16] + layer * 128;
#pragma unroll
        for (int d = 0; d < ND; ++d)
#pragma unroll
            for (int j = 0; j < 4; ++j) { const f32x4 gv = *(const GAS f32x4*)(gs + 32 * d + 8 * j + 4 * hi);
#pragma unroll
                for (int i = 0; i < 4; ++i) o[d][4 * j + i] *= rs * gv[i]; }
    }
#pragma unroll
    for (int d = 0; d < ND; ++d)
#pragma unroll
        for (int j = 0; j < 4; ++j) { u32x2 w; w.x = cvt_pk(o[d][4 * j], o[d][4 * j + 1]); w.y = cvt_pk(o[d][4 * j + 2], o[d][4 * j + 3]); *(GAS u32x2*)(Orow + 32 * d + 8 * j + 4 * hi) = w; }
}

template <int MODE>
__device__ __forceinline__ void attn_unit_naive(const WSP& W, const float* const* in, int layer, int b, int h, int qb, LAS unsigned char* lds) {
    int tid_ = threadIdx.x; asm volatile("" : "+v"(tid_)); const int tid = tid_; const size_t rowbase = (size_t)b * SEQ; const int q0 = qb * 256;
    if (MODE == 0) {
        if (tid < 256) {
            const int qpos = q0 + tid; const bf16_t* Qrow = W.qM + (rowbase + qpos) * 768;
            float q[96], acc[64];
#pragma unroll
            for (int d = 0; d < 64; ++d) { q[d] = bf2f(Qrow[64 * h + d]); acc[d] = 0.f; }
#pragma unroll
            for (int d = 0; d < 16; ++d) { const float x1 = bf2f(Qrow[512 + 32 * h + d]), x2 = bf2f(Qrow[512 + 32 * h + 16 + d]); const f32x2 cs = W.rope[(size_t)qpos * 16 + d];
                q[64 + d] = bf2f((bf16_t)(cvt_pk(x1 * cs.x - x2 * cs.y, 0.f) & 0xffffu)); q[80 + d] = bf2f((bf16_t)(cvt_pk(x2 * cs.x + x1 * cs.y, 0.f) & 0xffffu)); }
            float m = -1e30f, l = 0.f;
            for (int key = 0; key <= qpos; ++key) {
                const bf16_t* kp = W.kvM + (rowbase + key) * 1024 + 64 * h; const bf16_t* kr = W.zA + (rowbase + key) * 768 + 384; const bf16_t* vp = kp + 512;
                float s = 0.f;
#pragma unroll
                for (int d = 0; d < 64; ++d) s += q[d] * bf2f(kp[d]);
#pragma unroll
                for (int d = 0; d < 32; ++d) s += q[64 + d] * bf2f(kr[d]);
                const float mn = fmaxf(m, s), al = exp2f(m - mn), p = exp2f(s - mn); m = mn; l = l * al + p;
#pragma unroll
                for (int d = 0; d < 64; ++d) acc[d] = acc[d] * al + p * bf2f(vp[d]);
            }
            const float inv = 1.0f / l; bf16_t* O = W.qM + (rowbase + qpos) * 768 + 64 * h;
#pragma unroll
            for (int d = 0; d < 64; d += 2) *(unsigned*)(O + d) = cvt_pk(acc[d] * inv, acc[d + 1] * inv);
        }
    } else if (MODE == 2) {
        if (tid < 256) {
            const int qpos = q0 + tid; const bf16_t* Qrow = W.qC + (rowbase + qpos) * 512 + 64 * h;
            float q[64], acc[64];
#pragma unroll
            for (int d = 0; d < 64; ++d) { q[d] = bf2f(Qrow[d]); acc[d] = 0.f; }
            float run = 0.f;
            for (int key = qpos - 1; key >= 0; --key) {
                const bf16_t* kp = W.kC + (rowbase + key) * 512 + 64 * h; const bf16_t* vp = W.vC + (rowbase + key) * 512 + 64 * h;
                float s = 0.f;
#pragma unroll
                for (int d = 0; d < 64; ++d) s += q[d] * bf2f(kp[d]);
                const float z = s * LN2;
                const float sp = fmaxf(z, 0.f) + log1pf(expf(-fabsf(z)));
                const float w = expf((z - sp) + run);
                run -= sp;
#pragma unroll
                for (int d = 0; d < 64; ++d) acc[d] += w * bf2f(vp[d]);
            }
            bf16_t* O = W.qC + (rowbase + qpos) * 512 + 64 * h;
#pragma unroll
            for (int d = 0; d < 64; d += 2) *(unsigned*)(O + d) = cvt_pk(acc[d], acc[d + 1]);
        }
    } else {
        const int row = tid & 255, dh = tid >> 8; const int qpos = q0 + row;
        const float slope2 = exp2f(-2.0f * (float)(h + 1)) * LOG2E;
        float y[64];
#pragma unroll 1
        for (int pass = 0; pass < 2; ++pass) {
            const bf16_t* Qrow = W.qB + (rowbase + qpos) * 512 + 128 * h + 64 * pass;
            float q[64], acc[64];
#pragma unroll
            for (int d = 0; d < 64; ++d) { q[d] = bf2f(Qrow[d]); acc[d] = 0.f; }
            float m = -1e30f, l = 0.f;
            for (int key = 0; key <= qpos; ++key) {
                const bf16_t* kp = W.kB + (rowbase + key) * 512 + 128 * h + 64 * pass; const bf16_t* vp = W.vB + (rowbase + key) * 512 + 128 * h + 64 * dh;
                float s = slope2 * (float)(key - qpos);
#pragma unroll
                for (int d = 0; d < 64; ++d) s += q[d] * bf2f(kp[d]);
                const float mn = fmaxf(m, s), al = exp2f(m - mn), p = exp2f(s - mn); m = mn; l = l * al + p;
#pragma unroll
                for (int d = 0; d < 64; ++d) acc[d] = acc[d] * al + p * bf2f(vp[d]);
            }
            const float inv = 1.0f / l;
            if (pass == 0) {
#pragma unroll
                for (int d = 0; d < 64; ++d) y[d] = acc[d] * inv;
            } else {
                const float lam = diff_lambda(in, layer);
#pragma unroll
                for (int d = 0; d < 64; ++d) y[d] -= lam * acc[d] * inv;
            }
        }
        float ss = 0.f;
#pragma unroll
        for (int d = 0; d < 64; ++d) ss += y[d] * y[d];
        LAS float* xch = (LAS float*)(lds + A_XCH);
        __syncthreads(); xch[tid] = ss; __syncthreads();
        ss += xch[tid ^ 256];
        const float li = layer == 0 ? 0.2f : 0.35550906759f;
        const float rs = rsqrtf(ss * (1.0f / 128.0f) + EPS) * (1.0f - li);
        const float* gs = in[16] + layer * 128 + 64 * dh;
        bf16_t* O = W.qB + (rowbase + qpos) * 512 + 128 * h + 64 * dh;
        __syncthreads();
#pragma unroll
        for (int d = 0; d < 64; d += 2) *(unsigned*)(O + d) = cvt_pk(y[d] * rs * gs[d], y[d + 1] * rs * gs[d + 1]);
    }
}

constexpr int ATT_UNITS = 16 * 80;
__device__ __forceinline__ void attn_phase(const WSP& W, const float* const* in, int layer, LAS unsigned char* lds) {
    unsigned* counter = W.ctl + 64 * (1 + layer);
    for (;;) {
        __syncthreads();
        if (threadIdx.x == 0) *(volatile LAS unsigned*)(lds + A_IDX) = atomicAdd(counter, 1u);
        __syncthreads();
        const int idx = (int)__builtin_amdgcn_readfirstlane(*(volatile LAS unsigned*)(lds + A_IDX));
        if (idx >= ATT_UNITS) break;
        int w, qb;
        if (idx < 256) { qb = 15 - idx / 16; w = idx % 16; } else if (idx < 768) { qb = 15 - (idx - 256) / 32; w = 16 + (idx - 256) % 32; } else { qb = 15 - (idx - 768) / 32; w = 48 + (idx - 768) % 32; }
        if (w < 16) {
            if (NAIVE_ATTN & 2) attn_unit_naive<1>(W, in, layer, w >> 2, w & 3, qb, lds); else attn_unit<1>(W, in, layer, w >> 2, w & 3, qb, lds);
        } else if (w < 48) {
            const int v = w - 16;
            if (NAIVE_ATTN & 1) attn_unit_naive<0>(W, in, layer, v >> 3, v & 7, qb, lds); else attn_unit<0>(W, in, layer, v >> 3, v & 7, qb, lds);
        } else {
            const int v = w - 48;
            if (NAIVE_ATTN & 4) attn_unit_naive<2>(W, in, layer, v >> 3, v & 7, qb, lds); else attn_unit<2>(W, in, layer, v >> 3, v & 7, qb, lds);
        }
    }
}

#define LANEINFO() int tid_ = threadIdx.x; asm volatile("" : "+v"(tid_)); const int lane = tid_ & 63, wave = __builtin_amdgcn_readfirstlane(tid_ >> 6); \
    const int NGW = gridDim.x * 8, gw = blockIdx.x * 8 + wave; (void)wave; (void)gw; (void)NGW; (void)lane
enum { MAP_ID = 0, MAP_SWIGLU = 1, MAP_WIN = 2, MAP_UQ = 3, MAP_UKV = 4 };
__device__ __forceinline__ void conv_item(const float* src, const float* src2, int K, int Nsrc, bf16_t* dst, int ldd, int kofs, int nblk, int map, const float* gain, int item, int lane) {
    const int npair = nblk >> 1, kb = item / npair, np = item % npair, k0 = 64 * kb, nb = 2 * np + (lane >> 5);
    int sc = 32 * nb; float scale = 1.0f; const float* S = src;
    if (map == MAP_SWIGLU) { const int tile = nb >> 3, w = nb & 7; if (w < 4) sc = 128 * tile + 32 * w; else { sc = 128 * tile + 32 * (w - 4); S = src2; } }
    else if (map == MAP_WIN) {
        if (nb < 12) sc = 32 * nb; else if (nb == 12) sc = 640; else if (nb < 16) sc = -1; else if (nb < 24) sc = 384 + 32 * (nb - 16);
        else if (nb < 40) { sc = 672 + 32 * (nb - 24); scale = 0.125f * LOG2E; } else if (nb < 56) { sc = 2208 + 32 * (nb - 40); scale = 0.125f * LOG2E; }
        else if (nb < 72) sc = 1184 + 32 * (nb - 56); else if (nb < 88) sc = 1696 + 32 * (nb - 72); else if (nb < 104) sc = 2720 + 32 * (nb - 88); else sc = 3232 + 32 * (nb - 104);
    } else if (map == MAP_UQ) { scale = 0.10206207261596575f * LOG2E; if (nb < 16) sc = 96 * (nb >> 1) + 32 * (nb & 1); else sc = 96 * (nb - 16) + 64; }
    else if (map == MAP_UKV) { if (nb < 16) sc = 128 * (nb >> 1) + 32 * (nb & 1); else sc = 128 * ((nb - 16) >> 1) + 64 + 32 * ((nb - 16) & 1); }
    const bool zero = sc < 0;
    const GAS float* base = (const GAS float*)S + (size_t)k0 * Nsrc + (zero ? 0 : sc) + (lane & 31);
    GAS bf16_t* drow = (GAS bf16_t*)dst + (size_t)(32 * nb + (lane & 31)) * ldd + kofs + k0;
    float v[64];
    int ns_v = Nsrc; asm volatile("" : "+v"(ns_v));
#pragma unroll
    for (int i = 0; i < 64; ++i) v[i] = base[(size_t)((unsigned)i * (unsigned)ns_v)];
#pragma unroll
    for (int c = 0; c < 8; ++c) {
        float w[8];
#pragma unroll
        for (int i = 0; i < 8; ++i) { float g = scale; if (gain) g *= ((const GAS float*)gain)[k0 + 8 * c + i]; w[i] = zero ? 0.f : v[8 * c + i] * g; }
        u32x4 o; o.x = cvt_pk(w[0], w[1]); o.y = cvt_pk(w[2], w[3]); o.z = cvt_pk(w[4], w[5]); o.w = cvt_pk(w[6], w[7]);
        *(GAS u32x4*)(drow + 8 * c) = o;
    }
}
__device__ __forceinline__ void conv_phase(const WSP& W, const float* const* in, int l, LAS unsigned char* lds) {
    LANEINFO();
    bf16_t* WB = W.WB; int base = 0;
    const size_t LW = (size_t)DM * FF;
#pragma unroll 1
    for (int j = 0; j < 16; ++j) {
        const float* src; const float* src2 = nullptr; const float* gain = nullptr; bf16_t* dst; int K = DM, Nsrc = DM, ldd = DM, kofs = 0, nblk = DM / 32, map = MAP_ID;
        switch (j) {
        case 0: src = in[3] + l * LW; src2 = in[4] + l * LW; Nsrc = FF; dst = WB + W_UPA; nblk = 2 * FF / 32; map = MAP_SWIGLU; gain = in[2] + l * DM; break;
        case 1: src = in[5] + l * LW; K = FF; dst = WB + W_DNA; ldd = FF; break;
        case 2: src = in[7] + (size_t)l * DM * 3744; Nsrc = 3744; dst = WB + W_IN; nblk = 3840 / 32; map = MAP_WIN; gain = in[6] + l * DM; break;
        case 3: src = in[20] + (size_t)l * DM * 3072; Nsrc = 3072; dst = WB + W_GATE; nblk = 3072 / 32; gain = in[6] + l * DM; break;
        case 4: src = in[10] + (size_t)l * 384 * 768; K = 384; Nsrc = 768; dst = WB + W_UQ; ldd = 384; nblk = 768 / 32; map = MAP_UQ; gain = in[8] + l * 384; break;
        case 5: src = in[11] + (size_t)l * 256 * 1024; K = 256; Nsrc = 1024; dst = WB + W_UKV; ldd = 256; nblk = 1024 / 32; map = MAP_UKV; gain = in[9] + l * 256; break;
        case 6: src = in[17] + (size_t)l * 512 * DM; K = 512; dst = WB + W_O; ldd = 512; break;
        case 7: src = in[18] + (size_t)l * 512 * DM; K = 512; dst = WB + W_O + 524288; ldd = 512; break;
        case 8: src = in[19] + (size_t)l * 512 * DM; K = 512; dst = WB + W_O + 2 * 524288; ldd = 512; break;
        case 9: src = in[21] + (size_t)l * DM * DM; dst = WB + W_OUT3; break;
        case 10: case 11: continue;
        case 12: src = in[23] + l * LW; src2 = in[24] + l * LW; Nsrc = FF; dst = WB + W_UPB; nblk = 2 * FF / 32; map = MAP_SWIGLU; gain = in[22] + l * DM; break;
        case 13: src = in[25] + l * LW; K = FF; dst = WB + W_DNB; ldd = FF; break;
        case 14: src = in[27] + (size_t)l * DM * DM; dst = WB + W_PG; gain = in[26] + l * DM; break;
        default: src = in[28] + (size_t)l * PLE * DM; K = PLE; dst = WB + W_PE; ldd = PLE; break;
        }
        const int n_ = (K / 64) * (nblk >> 1);
        for (int it_ = base + ((gw - base % NGW + NGW) % NGW); it_ < base + n_; it_ += NGW) conv_item(src, src2, K, Nsrc, dst, ldd, kofs, nblk, map, gain, it_ - base, lane);
        base += n_;
    }
    const GAS f32x4* ps = (const GAS f32x4*)(in[1] + (size_t)l * TOK * PLE);
    const int gt = gw * 64 + lane, NGT = NGW * 64;
    for (int i = gt; i < TOK * PLE / 8; i += NGT) { const f32x4 a = ps[2 * i], b = ps[2 * i + 1]; *(GAS u32x4*)(W.PBF + (size_t)i * 8) = pack8(a, b); }
}
__device__ __forceinline__ void prologue_phase(const WSP& W, const float* const* in) {
    LANEINFO();
    const int gt = gw * 64 + lane, NGT = NGW * 64;
    for (int e = gt; e < SEQ * 16; e += NGT) {
        const int pos = e >> 4, i = e & 15;
        const float freq = 1.0f / powf(10000.0f, (float)i * (1.0f / 16.0f));
        const float ang = (float)pos * freq;
        const double rev = (double)ang * 0.15915494309189535;
        const float fr = (float)(rev - rint(rev));
        ((GAS f32x2*)W.rope)[e] = (f32x2){__builtin_amdgcn_cosf(fr), __builtin_amdgcn_sinf(fr)};
    }
    const float* x = in[0];
    for (int row = gw; row < TOK; row += 2 * NGW) {
        const int row2 = row + NGW; const bool has2 = row2 < TOK;
        const GAS f32x4* xa = (const GAS f32x4*)(x + (size_t)row * DM); const GAS f32x4* xb = (const GAS f32x4*)(x + (size_t)(has2 ? row2 : row) * DM);
        f32x4 a[4], c[4];
#pragma unroll
        for (int j = 0; j < 2; ++j) { a[2 * j] = xa[128 * j + 2 * lane]; a[2 * j + 1] = xa[128 * j + 2 * lane + 1]; c[2 * j] = xb[128 * j + 2 * lane]; c[2 * j + 1] = xb[128 * j + 2 * lane + 1]; }
        float ss = 0.f, s2 = 0.f;
#pragma unroll
        for (int j = 0; j < 4; ++j) { ss += (a[j][0] * a[j][0] + a[j][1] * a[j][1]) + (a[j][2] * a[j][2] + a[j][3] * a[j][3]); s2 += (c[j][0] * c[j][0] + c[j][1] * c[j][1]) + (c[j][2] * c[j][2] + c[j][3] * c[j][3]); }
#pragma unroll
        for (int j = 0; j < 2; ++j) { *(GAS u32x4*)(W.HB2 + (size_t)row * DM + 512 * j + 8 * lane) = pack8(a[2 * j], a[2 * j + 1]);
            if (has2) *(GAS u32x4*)(W.HB2 + (size_t)row2 * DM + 512 * j + 8 * lane) = pack8(c[2 * j], c[2 * j + 1]); }
        ss = wave_sum(ss); s2 = wave_sum(s2);
        if (lane < 16) { ((GAS float*)W.stats0)[(size_t)row * 16 + lane] = (lane == 0) ? ss : 0.f; if (has2) ((GAS float*)W.stats0)[(size_t)row2 * 16 + lane] = (lane == 0) ? s2 : 0.f; }
    }
}
__device__ __forceinline__ void mla_prep_phase(const WSP& W) {
    LANEINFO();
    for (int row = gw; row < TOK; row += NGW) {
        GAS bf16_t* z = (GAS bf16_t*)(W.zA + (size_t)row * 768);
        const GAS unsigned* zq = (const GAS unsigned*)(z + 6 * lane); const GAS unsigned* zk = (const GAS unsigned*)(z + 512 + 4 * lane);
        const unsigned a0 = zq[0], a1 = zq[1], a2 = zq[2], b0 = zk[0], b1 = zk[1];
        float sq = bflo(a0) * bflo(a0) + bfhi(a0) * bfhi(a0) + bflo(a1) * bflo(a1) + bfhi(a1) * bfhi(a1) + bflo(a2) * bflo(a2) + bfhi(a2) * bfhi(a2);
        float sk = bflo(b0) * bflo(b0) + bfhi(b0) * bfhi(b0) + bflo(b1) * bflo(b1) + bfhi(b1) * bfhi(b1);
        sq = wave_sum(sq); sk = wave_sum(sk);
        if (lane == 0) { GAS float* sq_ = (GAS float*)W.statq; sq_[2 * (size_t)row] = rsqrtf(sq * (1.0f / 384.0f) + EPS); sq_[2 * (size_t)row + 1] = rsqrtf(sk * (1.0f / 256.0f) + EPS); }
        if (lane < 16) {
            const float x1 = bf2f(z[384 + lane]), x2 = bf2f(z[400 + lane]); const f32x2 cs = ((const GAS f32x2*)W.rope)[(size_t)(row & (SEQ - 1)) * 16 + lane];
            const unsigned o = cvt_pk(x1 * cs.x - x2 * cs.y, x2 * cs.x + x1 * cs.y);
            z[384 + lane] = (bf16_t)(o & 0xffffu); z[400 + lane] = (bf16_t)(o >> 16);
        }
    }
}
__device__ __forceinline__ void final_phase(const WSP& W, const float* gfin, float* out) {
    LANEINFO();
    const GAS f32x4* g = (const GAS f32x4*)gfin;
    f32x4 gv[4];
#pragma unroll
    for (int j = 0; j < 2; ++j) { gv[2 * j] = g[128 * j + 2 * lane]; gv[2 * j + 1] = g[128 * j + 2 * lane + 1]; }
    for (int row = gw; row < TOK; row += 2 * NGW) {
        const int row2 = row + NGW; const bool has2 = row2 < TOK; const int rb = has2 ? row2 : row;
        const f32x4 sa = *(const GAS f32x4*)(W.stats0 + (size_t)row * 16 + 4 * (lane & 3)), sb = *(const GAS f32x4*)(W.stats0 + (size_t)rb * 16 + 4 * (lane & 3));
        const GAS u32x4* ha = (const GAS u32x4*)(W.HB2 + (size_t)row * DM); const GAS u32x4* hb = (const GAS u32x4*)(W.HB2 + (size_t)rb * DM);
        u32x4 wa[2], wb[2];
#pragma unroll
        for (int j = 0; j < 2; ++j) { wa[j] = ha[64 * j + lane]; wb[j] = hb[64 * j + lane]; }
        float s = (sa[0] + sa[1]) + (sa[2] + sa[3]); s += __shfl_xor(s, 1); s += __shfl_xor(s, 2);
        float t = (sb[0] + sb[1]) + (sb[2] + sb[3]); t += __shfl_xor(t, 1); t += __shfl_xor(t, 2);
        const float rs = rsqrtf(s * (1.0f / DM) + EPS), rt = rsqrtf(t * (1.0f / DM) + EPS);
        GAS f32x4* oa = (GAS f32x4*)(out + (size_t)row * DM); GAS f32x4* ob = (GAS f32x4*)(out + (size_t)rb * DM);
#pragma unroll
        for (int j = 0; j < 2; ++j) {
            const f32x4 a0 = (f32x4){bflo(wa[j].x), bfhi(wa[j].x), bflo(wa[j].y), bfhi(wa[j].y)}, a1 = (f32x4){bflo(wa[j].z), bfhi(wa[j].z), bflo(wa[j].w), bfhi(wa[j].w)};
            oa[128 * j + 2 * lane] = a0 * rs * gv[2 * j]; oa[128 * j + 2 * lane + 1] = a1 * rs * gv[2 * j + 1];
            if (has2) { const f32x4 b0 = (f32x4){bflo(wb[j].x), bfhi(wb[j].x), bflo(wb[j].y), bfhi(wb[j].y)}, b1 = (f32x4){bflo(wb[j].z), bfhi(wb[j].z), bflo(wb[j].w), bfhi(wb[j].w)};
                ob[128 * j + 2 * lane] = b0 * rt * gv[2 * j]; ob[128 * j + 2 * lane + 1] = b1 * rt * gv[2 * j + 1]; }
        }
    }
}

#define XB_TMO      128
#define XB_XCNT(j)  (256  + 64 * (j))
#define XB_XSUB(j)  (1280 + 64 * (j))
#define XB_XGEN(j)  (2304 + 64 * (j))
#define XB_TOP      3328
#define XB_TOPGEN   3392
#define XCD_BAR_WORDS 3456
#define XB_SPIN_CAP (1u << 18)

__device__ __forceinline__ unsigned xb_ld(unsigned* p)              { return __hip_atomic_load(p, __ATOMIC_RELAXED, __HIP_MEMORY_SCOPE_AGENT); }
__device__ __forceinline__ unsigned xb_add(unsigned* p, unsigned v) { return __hip_atomic_fetch_add(p, v, __ATOMIC_RELAXED, __HIP_MEMORY_SCOPE_AGENT); }
__device__ __forceinline__ unsigned xb_xcc_id() { return (unsigned)__builtin_amdgcn_s_getreg((3 << 11) | 20) & 0xFu; }
#define XB_SPIN(cond, bar) do { unsigned _sp = 0; while (cond) { __builtin_amdgcn_s_sleep(1); \
    if ((++_sp & 255u) == 0u) { if (xb_ld(&(bar)[XB_TMO])) break; if (_sp > XB_SPIN_CAP) { atomicAdd(&(bar)[XB_TMO], 1u); break; } } } } while (0)

struct XcdBarrier {
    unsigned* bar; unsigned x;
    volatile LAS unsigned* st;
};

__device__ __forceinline__ XcdBarrier xcd_barrier_post(unsigned* bar, volatile LAS unsigned* st) {
    XcdBarrier b; b.bar = bar; b.x = xb_xcc_id(); b.st = st;
    if (threadIdx.x == 0) (void)xb_add(&bar[XB_XCNT(b.x)], 1u);
    return b;
}
__device__ __forceinline__ void xcd_barrier_complete(unsigned* bar, unsigned x, unsigned& nloc, unsigned& nx) {
    const unsigned G = gridDim.x * gridDim.y * gridDim.z;
    unsigned sum, cnt, mine, sp = 0u;
    for (;;) {
        sum = 0u; cnt = 0u; mine = 0u;
#pragma unroll
        for (unsigned j = 0; j < 16; ++j) { const unsigned c = xb_ld(&bar[XB_XCNT(j)]); sum += c; cnt += (c > 0u) ? 1u : 0u; mine = (j == x) ? c : mine; }
        if (sum == G) break;
        __builtin_amdgcn_s_sleep(1);
        if ((++sp & 255u) == 0u) { if (xb_ld(&bar[XB_TMO])) break; if (sp > XB_SPIN_CAP) { atomicAdd(&bar[XB_TMO], 1u); break; } }
    }
    nloc = mine > 0u ? mine : 1u; nx = cnt > 0u ? cnt : 1u;
}

__device__ __forceinline__ void xcd_barrier(const XcdBarrier& b) {
    asm volatile("s_waitcnt vmcnt(0)" ::: "memory");
    __syncthreads();
    if (threadIdx.x == 0) {
        unsigned* bar = b.bar;
        __builtin_amdgcn_s_waitcnt(0);
        unsigned nloc = b.st[0], nx = b.st[1];
        if (nloc == 0u) { xcd_barrier_complete(bar, b.x, nloc, nx); b.st[0] = nloc; b.st[1] = nx; }
        const unsigned old = xb_add(&bar[XB_XSUB(b.x)], 1u);
        const unsigned gen = old / nloc;
        if (old + 1u == (gen + 1u) * nloc) {
            __builtin_amdgcn_fence(__ATOMIC_RELEASE, "agent");
            asm volatile("s_waitcnt vmcnt(0)" ::: "memory");
            const unsigned og = xb_add(&bar[XB_TOP], 1u);
            const unsigned tg = og / nx;
            if (og + 1u == (tg + 1u) * nx) xb_add(&bar[XB_TOPGEN], 1u);
            else XB_SPIN(xb_ld(&bar[XB_TOPGEN]) == tg, bar);
            __builtin_amdgcn_fence(__ATOMIC_ACQUIRE, "agent");
            xb_add(&bar[XB_XGEN(b.x)], 1u);
            asm volatile("s_waitcnt vmcnt(0)" ::: "memory");
        } else {
            XB_SPIN(xb_ld(&bar[XB_XGEN(b.x)]) == gen, bar);
            __builtin_amdgcn_fence(__ATOMIC_ACQUIRE, "agent");
            asm volatile("s_waitcnt vmcnt(0)" ::: "memory");
        }
    }
    __syncthreads();
}

constexpr int NTHREADS = 512, LDS_BYTES = 147456;
constexpr int PH_PER_LAYER = 12, PH_FINAL = 24, PH_TOTAL = 25;
struct Args { const float* in[30]; float* out; unsigned char* ws; int ph_lo, ph_hi; };

template <class Epi, class Sched>
__device__ __forceinline__ void run_gemm(LAS unsigned char* lds, const pg8::Gemm g, const Sched& S, const Epi& E) {
#if NAIVE_GEMM
    pg8::gemm_naive<Epi, Sched>(g, S, E);
#else
    pg8::gemm_phase<Epi, Sched, true, true>(lds, g, S, E);
#endif
}

__global__ void __launch_bounds__(NTHREADS, 2) fwd_megakernel(Args args) {
    extern __shared__ __attribute__((aligned(16))) unsigned char lds_raw[];
    LAS unsigned char* lds = (LAS unsigned char*)lds_raw;
    cg::grid_group grid = cg::this_grid();
    const int G = gridDim.x, bx = blockIdx.x;
#define MKW() unsigned char* ws = args.ws; asm volatile("" : "+s"(ws)); const float* const* in = args.in; WSP W; \
    W.ctl = (unsigned*)(ws + WS_CTL); W.rope = (f32x2*)(ws + WS_ROPE); W.stats0 = (float*)(ws + WS_STATS0); W.stats1 = (float*)(ws + WS_STATS1); W.statq = (float*)(ws + WS_STATQ); \
    W.WB = (bf16_t*)(ws + WS_WB); W.HB = (bf16_t*)(ws + WS_HB); W.HB2 = (bf16_t*)(ws + WS_HB2); W.PBF = (bf16_t*)(ws + WS_PBF); W.zA = (bf16_t*)(ws + WS_ZA); W.qM = (bf16_t*)(ws + WS_QM); \
    W.qB = (bf16_t*)(ws + WS_QB); W.qC = (bf16_t*)(ws + WS_QC); W.kB = (bf16_t*)(ws + WS_KB); W.vB = (bf16_t*)(ws + WS_VB); W.kC = (bf16_t*)(ws + WS_KC); W.vC = (bf16_t*)(ws + WS_VC); \
    W.kvM = (bf16_t*)(ws + WS_KVM); W.X = (bf16_t*)(ws + WS_X); W.FFH = (bf16_t*)(ws + WS_FFH); W.PE = (bf16_t*)(ws + WS_PE); W.Xm = (bf16_t*)(ws + WS_XM);
    float* out = args.out;
    const int lo = args.ph_lo, hi = args.ph_hi;
#define IN(k) (lo <= (k) && (k) < hi)
    constexpr size_t WS_BAR = 65536;
    LAS unsigned* bar_st = (LAS unsigned*)(lds + LDS_BYTES - 64);
    if (threadIdx.x < 2) bar_st[threadIdx.x] = 0u;
    __syncthreads();
    XcdBarrier xbar; xbar.bar = (unsigned*)(args.ws + WS_BAR); xbar.x = xb_xcc_id(); xbar.st = (volatile LAS unsigned*)bar_st;
#define SEAM(k) do { if ((k) + 1 < hi) { if ((k) == lo) { asm volatile("s_waitcnt vmcnt(0) lgkmcnt(0)" ::: "memory"); grid.sync(); \
        if (threadIdx.x == 0) { asm volatile("buffer_inv sc1\n\ts_waitcnt vmcnt(0)" ::: "memory"); (void)xb_add(&xbar.bar[XB_XCNT(xbar.x)], 1u); } __syncthreads(); } \
        else xcd_barrier(xbar); } } while (0)
    using pg8::Gemm; using pg8::StaticOrder; using pg8::PanelOrder;
#pragma unroll 1
    for (int l = 0; l < 2; ++l) {
        const int pb = PH_PER_LAYER * l;
        if (IN(pb + 0)) { MKW(); if (bx == 0 && threadIdx.x == 0) W.ctl[64 * (1 + l)] = 0u; if (bx == 0 && l == 0) { int t0_ = threadIdx.x; asm volatile("" : "+v"(t0_)); for (int k_ = 0; k_ < (XCD_BAR_WORDS + NTHREADS - 1) / NTHREADS; ++k_) { const int i_ = t0_ + NTHREADS * k_; if (i_ < XCD_BAR_WORDS) ((GAS unsigned*)(args.ws + 65536))[i_] = 0u; } }     conv_phase(W, in, l, lds); if (l == 0) prologue_phase(W, in); __syncthreads(); SEAM(pb + 0); }
        if (IN(pb + 1)) { MKW(); Gemm g{W.HB2, W.WB + W_UPA, TOK, 2 * FF, DM, DM}; StaticOrder S; S.init(TOK, 2 * FF, G, bx);
            EpiSwiglu E{W.FFH, W.stats0}; run_gemm(lds, g, S, E); SEAM(pb + 1); }
        if (IN(pb + 2)) { MKW(); Gemm g{W.FFH, W.WB + W_DNA, TOK, DM, FF, FF}; StaticOrder S; S.init(TOK, DM, G, bx);
            EpiResid<false> E{W.HB2, W.HB, W.stats1, 0.5f, nullptr, nullptr}; run_gemm(lds, g, S, E); SEAM(pb + 2); }
        if (IN(pb + 3)) { MKW(); Gemm g{W.HB, W.WB + W_IN, TOK, 3840, DM, DM}; StaticOrder S; S.init(TOK, 3840, G, bx);
            EpiInproj E{W.zA, W.qB, W.stats1}; run_gemm(lds, g, S, E); SEAM(pb + 3); }
        if (IN(pb + 4)) { MKW(); mla_prep_phase(W); SEAM(pb + 4); }
        if (IN(pb + 5)) { MKW();
            { Gemm g{W.zA, W.WB + W_UQ, TOK, 768, 384, 768}; StaticOrder S; S.init(TOK, 768, G, bx); EpiStore E{W.qM, 768, W.statq}; run_gemm(lds, g, S, E); }
            { Gemm g{W.zA + 512, W.WB + W_UKV, TOK, 1024, 256, 768}; StaticOrder S; S.init(TOK, 1024, G, bx); EpiStore E{W.kvM, 1024, W.statq + 1}; run_gemm(lds, g, S, E); }
            SEAM(pb + 5); }
        if (IN(pb + 6)) { MKW(); attn_phase(W, in, l, lds); SEAM(pb + 6); }
        if (IN(pb + 7)) { MKW();
            for (int tile = bx; tile < 256; tile += G) {
                const int pm = 8 * (tile & 7) + ((tile >> 3) & 7), pnq = tile >> 6;
                { Gemm g{W.HB, W.WB + W_GATE, TOK, 3072, DM, DM}; PanelOrder S{pm, pnq, 4, 3}; EpiGates E{W.X, W.stats1}; run_gemm(lds, g, S, E); }
                { Gemm g{W.qM, W.WB + W_O, TOK, DM, 512, 768}; PanelOrder S{pm, pnq, 0, 1}; EpiMulGateAcc E{W.X, W.Xm, 0}; run_gemm(lds, g, S, E); }
                { Gemm g{W.qB, W.WB + W_O + 524288, TOK, DM, 512, 512}; PanelOrder S{pm, pnq, 0, 1}; EpiMulGateAcc E{W.X, W.Xm, 1}; run_gemm(lds, g, S, E); }
                { Gemm g{W.qC, W.WB + W_O + 2 * 524288, TOK, DM, 512, 512}; PanelOrder S{pm, pnq, 0, 1}; EpiMulGateAcc E{W.X, W.Xm, 2}; run_gemm(lds, g, S, E); }
            }
            SEAM(pb + 7); }
        if (IN(pb + 8)) { MKW(); Gemm g{W.Xm, W.WB + W_OUT3, TOK, DM, DM, DM}; StaticOrder S; S.init(TOK, DM, G, bx);
            EpiResid<false> E{W.HB, W.HB, W.stats0, 1.0f, nullptr, nullptr}; run_gemm(lds, g, S, E); SEAM(pb + 8); }
        if (IN(pb + 9)) { MKW(); Gemm g{W.HB, W.WB + W_UPB, TOK, 2 * FF, DM, DM}; StaticOrder S; S.init(TOK, 2 * FF, G, bx);
            EpiSwiglu E{W.FFH, W.stats0}; run_gemm(lds, g, S, E);
            { const int G2 = G - G / 2; Gemm g2{W.PBF, W.WB + W_PE, TOK, DM, PLE, PLE}; StaticOrder S2; S2.init(TOK, DM, G2, bx >= G / 2 ? bx - G / 2 : (1 << 20)); EpiStore E2{W.PE, DM, nullptr}; run_gemm(lds, g2, S2, E2); }
            SEAM(pb + 9); }
        if (IN(pb + 10)) { MKW();
            { Gemm g{W.FFH, W.WB + W_DNB, TOK, DM, FF, FF}; StaticOrder S; S.init(TOK, DM, G, bx); EpiResid<false> E{W.HB, W.HB, W.stats1, 0.5f, nullptr, nullptr}; run_gemm(lds, g, S, E); }
            SEAM(pb + 10); }
        if (IN(pb + 11)) { MKW(); Gemm g{W.HB, W.WB + W_PG, TOK, DM, DM, DM}; StaticOrder S; S.init(TOK, DM, G, bx);
            EpiResid<true> E{W.HB, W.HB2, W.stats0, 1.0f, W.stats1, W.PE}; run_gemm(lds, g, S, E); SEAM(pb + 11); }
    }
    if (IN(PH_FINAL)) { MKW(); final_phase(W, in[29], out); }
#undef IN
#undef SEAM
}

extern "C" void kernel_launch(void* const* d_in, const int* in_sizes, int n_in, void* d_out, int out_size, void* d_ws, size_t ws_size, hipStream_t stream) {
    static int grid = 0;
    if (grid == 0) {
        if (n_in != 30 || out_size != TOK * DM || ws_size < WS_END) { fprintf(stderr, "kernel_launch: unexpected problem (n_in %d, out %d, ws %zu)\n", n_in, out_size, ws_size); grid = -1; return; }
        int dev = 0, cus = 0, per_cu = 0;
        hipGetDevice(&dev); hipDeviceGetAttribute(&cus, hipDeviceAttributeMultiprocessorCount, dev);
        if (hipFuncSetAttribute((const void*)fwd_megakernel, hipFuncAttributeMaxDynamicSharedMemorySize, LDS_BYTES) != hipSuccess) { fprintf(stderr, "kernel_launch: hipFuncSetAttribute failed\n"); grid = -1; return; }
        if (hipOccupancyMaxActiveBlocksPerMultiprocessor(&per_cu, (const void*)fwd_megakernel, NTHREADS, LDS_BYTES) != hipSuccess || per_cu < 1) per_cu = 1;
        (void)hipGetLastError();
        grid = cus * per_cu;
        if (grid > 256) grid = 256;
    }
    if (grid < 0) return;
    Args a{};
    for (int i = 0; i < 30; ++i) a.in[i] = (const float*)d_in[i];
    a.out = (float*)d_out; a.ws = (unsigned char*)d_ws;
#if N_LAUNCH_MODE
    a.ph_lo = 0; a.ph_hi = PH_TOTAL;
    void* kargs[] = {&a};
    hipError_t e = hipLaunchCooperativeKernel((const void*)fwd_megakernel, dim3(grid), dim3(NTHREADS), kargs, LDS_BYTES, stream);
    if (e != hipSuccess) fprintf(stderr, "cooperative launch failed: %s (grid %d)\n", hipGetErrorString(e), grid);
#else
    for (int p = 0; p < PH_TOTAL; ++p) { a.ph_lo = p; a.ph_hi = p + 1; hipLaunchKernelGGL(fwd_megakernel, dim3(grid), dim3(NTHREADS), LDS_BYTES, stream, a); }
#endif
}
```

```cpp
#include <hip/hip_runtime.h>
#include <hip/hip_cooperative_groups.h>
#include <cstdio>
#include <cstdint>
#include <cmath>
namespace cg = cooperative_groups;

#ifndef NAIVE_GEMM
#define NAIVE_GEMM 0
#endif
#ifndef NAIVE_ATTN
#define NAIVE_ATTN 0
#endif
#ifndef N_LAUNCH_MODE
#define N_LAUNCH_MODE 1
#endif

#define PG8_LAS __attribute__((address_space(3)))
#define LAS __attribute__((address_space(3)))
#define GAS __attribute__((address_space(1)))
typedef unsigned short bf16_t;
typedef short bf16x8 __attribute__((ext_vector_type(8)));
typedef float f32x4 __attribute__((ext_vector_type(4)));
typedef float f32x2 __attribute__((ext_vector_type(2)));
typedef float f32x16 __attribute__((ext_vector_type(16)));
typedef unsigned u32x4 __attribute__((ext_vector_type(4)));
typedef unsigned u32x2 __attribute__((ext_vector_type(2)));
typedef short v4i16_t __attribute__((ext_vector_type(4)));

constexpr int BATCH = 4, SEQ = 4096, TOK = BATCH * SEQ, DM = 1024, FF = 2816, PLE = 256;
constexpr float EPS = 1e-6f, LOG2E = 1.4426950408889634f, LN2 = 0.6931471805599453f;
constexpr size_t MiB = 1u << 20;
constexpr size_t WS_CTL = 0, CTL_BYTES = 4096;
constexpr size_t WS_ROPE = 1 * MiB;
constexpr size_t WS_STATS0 = 2 * MiB, WS_STATS1 = 3 * MiB;
constexpr size_t WS_STATQ = 4 * MiB;
constexpr size_t WS_WB = 6 * MiB;
constexpr size_t WS_HB = 66 * MiB;
constexpr size_t WS_PBF = 98 * MiB;
constexpr size_t WS_ZA = 106 * MiB;
constexpr size_t WS_QM = 130 * MiB;
constexpr size_t WS_QB = 154 * MiB;
constexpr size_t WS_QC = 170 * MiB, WS_KB = 186 * MiB, WS_VB = 202 * MiB, WS_KC = 218 * MiB, WS_VC = 234 * MiB;
constexpr size_t WS_KVM = 250 * MiB;
constexpr size_t WS_X = 186 * MiB;
constexpr size_t WS_FFH = 186 * MiB;
constexpr size_t WS_PE = 106 * MiB;
constexpr size_t WS_HB2 = 154 * MiB;
constexpr size_t WS_XM = 282 * MiB;
constexpr size_t WS_END = 314 * MiB;
constexpr size_t W_UPA = 0, W_DNA = 5767168, W_IN = 8650752, W_GATE = 12582912, W_UQ = 15728640, W_UKV = 16023552, W_O = 16285696,
                 W_OUT3 = 17858560, W_UPB = 21004288, W_DNB = 26771456, W_PG = 29655040, W_PE = 30703616, W_TOTAL = 30965760;
static_assert(WS_WB + W_TOTAL * 2 <= WS_HB, "weights fit");

typedef __bf16 bf16x2_t __attribute__((ext_vector_type(2)));
__device__ __forceinline__ unsigned cvt_pk(float lo, float hi) { f32x2 v = {lo, hi}; bf16x2_t b = __builtin_convertvector(v, bf16x2_t); return __builtin_bit_cast(unsigned, b); }
__device__ __forceinline__ float bflo(unsigned w) { return __uint_as_float(w << 16); }
__device__ __forceinline__ float bfhi(unsigned w) { return __uint_as_float(w & 0xffff0000u); }
__device__ __forceinline__ float bf2f(bf16_t b) { return __uint_as_float((unsigned)b << 16); }
__device__ __forceinline__ float fsigmoid(float x) { return __builtin_amdgcn_rcpf(1.0f + __builtin_amdgcn_exp2f(-x * LOG2E)); }
__device__ __forceinline__ float wave_sum(float v) {
#pragma unroll
    for (int o = 1; o < 64; o <<= 1) v += __shfl_xor(v, o);
    return v;
}

namespace pg8 {
constexpr int BM = 256, BK = 64, HALF = 128, HTB = HALF * BK * 2, STAGE_BYTES = 8 * HTB, NXCD = 8, WGM = 4;
__host__ __device__ __forceinline__ int lds_byte(int r, int c) { const int st = (r >> 4) * 2 + (c >> 5), rr = r & 15, cc = c & 31, ob = rr * 64 + cc * 2; return st * 1024 + (ob ^ (((ob >> 9) & 1) << 5)); }
__host__ __device__ __forceinline__ void stage_rc(int b, int& R, int& C) { const int st = b / 1024, sb = b % 1024, swz = sb ^ (((sb >> 9) & 1) << 5); R = (st >> 1) * 16 + swz / 64; C = (st & 1) * 32 + (swz % 64) / 2; }
__host__ __device__ __forceinline__ int perm32(int rho) { const int n = rho >> 4, i = rho & 15; return 8 * (i >> 2) + 4 * n + (i & 3); }

struct Unit { int pm, pn; };
struct Gemm { const bf16_t* A; const bf16_t* Bt; int M, N, K, lda; };

struct StaticOrder {
    int nM, nN, nwg, G, c;
    __host__ __device__ void init(int M, int N, int G_, int c_) { nM = M / BM; nN = N / BM; nwg = nM * nN; G = G_; c = c_; }
    __host__ __device__ bool next(int i, Unit& u) const {
        const long L = (long)i * G + c; if (L >= nwg) return false;
        int wgid = (int)L; { const int q = nwg / NXCD, r = nwg % NXCD, xcd = wgid % NXCD, off = wgid / NXCD; wgid = (xcd < r ? xcd * (q + 1) : r * (q + 1) + (xcd - r) * q) + off; }
        const int nig = WGM * nN, gid = wgid / nig, fm = gid * WGM, gsz = (nM - fm) < WGM ? (nM - fm) : WGM;
        u.pm = fm + ((wgid % nig) % gsz); u.pn = (wgid % nig) / gsz; return true;
    }
    __device__ __forceinline__ void a_ready(const Unit&) const {}
    __device__ __forceinline__ void done(const Unit&) const {}
};
struct PanelOrder {
    int pm, pn0, step, cnt;
    __device__ bool next(int i, Unit& u) const { if (i >= cnt) return false; u.pm = pm; u.pn = pn0 + step * i; return true; }
    __device__ __forceinline__ void a_ready(const Unit&) const {}
    __device__ __forceinline__ void done(const Unit&) const {}
};
template <class Epi, class Sched, bool ALIGN_EPI = false, bool SP2 = false>
__device__ __forceinline__ void gemm_phase(PG8_LAS unsigned char* lds, const Gemm g, const Sched& S, const Epi& E) {
    int tid_ = threadIdx.x; asm volatile("" : "+v"(tid_));
    const int tid = tid_, wid = __builtin_amdgcn_readfirstlane(tid >> 6), lane = tid & 63, wr = wid >> 2, wc = wid & 3, fr = lane & 15, fq = lane >> 4;
    const int K = g.K, nt = K / BK;
    unsigned voffA[2], voffB[2];
#pragma unroll
    for (int i = 0; i < 2; ++i) { int R, C; stage_rc(tid * 16 + i * 8192, R, C); const int Rb = Epi::PERM ? ((R & ~31) + perm32(R & 31)) : R;
        voffA[i] = (unsigned)(R * g.lda + C) * 2u; voffB[i] = (unsigned)(Rb * K + C) * 2u; }
    const size_t kstep = (size_t)(BK * 2);
    const size_t hstepA = (size_t)HALF * g.lda * 2, hstepB = (size_t)HALF * K * 2;
    const size_t tstepA = 2 * hstepA, tstepB = 2 * hstepB;
    const unsigned ldsw = (unsigned)wid * 1024u;
    const int aoff = lds_byte(wr * 64 + fr, fq * 8), boff = lds_byte(wc * 32 + fr, fq * 8);
#define PG8_SA(b, h) (((b) * 2 + (h)) * HTB)
#define PG8_SB(b, h) ((4 + (b) * 2 + (h)) * HTB)
#define PG8_STAGE(bufoff, gbase, voff) do { _Pragma("unroll") for (int _i = 0; _i < 2; ++_i) \
        __builtin_amdgcn_global_load_lds((const unsigned*)((const char*)(gbase) + (voff)[_i]), (PG8_LAS unsigned*)(lds + (bufoff) + ldsw + _i * 8192), 16, 0, 0); } while (0)
#define PG8_LDA(dst, b, h) do { _Pragma("unroll") for (int m = 0; m < 4; ++m) _Pragma("unroll") for (int k = 0; k < 2; ++k) dst[m][k] = *(const PG8_LAS bf16x8*)(lds + PG8_SA(b, h) + aoff + m * 2048 + k * 1024); } while (0)
#define PG8_LDB(dst, b, h) do { _Pragma("unroll") for (int n = 0; n < 2; ++n) _Pragma("unroll") for (int k = 0; k < 2; ++k) dst[n][k] = *(const PG8_LAS bf16x8*)(lds + PG8_SB(b, h) + boff + n * 2048 + k * 1024); } while (0)
#define PG8_MMA(ai, bj, At, Bt) do { __builtin_amdgcn_s_setprio(1); _Pragma("unroll") for (int m = 0; m < 4; ++m) _Pragma("unroll") for (int n = 0; n < 2; ++n) _Pragma("unroll") for (int k = 0; k < 2; ++k) \
        acc[ai][bj][m][n] = __builtin_amdgcn_mfma_f32_16x16x32_bf16(Bt[n][k], At[m][k], acc[ai][bj][m][n], 0, 0, 0); __builtin_amdgcn_s_setprio(0); } while (0)
#define PG8_WAIT_V(n) asm volatile("s_waitcnt vmcnt(" #n ")" ::: "memory")
#define PG8_WAIT_L(n) asm volatile("s_waitcnt lgkmcnt(" #n ")" ::: "memory")
#define PG8_BAR __builtin_amdgcn_s_barrier()
#define PG8_SCHED __builtin_amdgcn_sched_barrier(0)
    Unit cur, nxt; int ui = 0;
    if (!S.next(0, cur)) return;
    f32x4 acc[2][2][4][2];
#pragma unroll
    for (int a = 0; a < 2; ++a)
#pragma unroll
        for (int b = 0; b < 2; ++b)
#pragma unroll
            for (int m = 0; m < 4; ++m)
#pragma unroll
                for (int n = 0; n < 2; ++n) acc[a][b][m][n] = (f32x4){0.f, 0.f, 0.f, 0.f};
    bf16x8 At[4][2], B0[2][2], B1[2][2];
    const char* cA = (const char*)g.A + (size_t)cur.pm * tstepA; const char* cB = (const char*)g.Bt + (size_t)cur.pn * tstepB;
    S.a_ready(cur);
    if constexpr (SP2) {
        PG8_STAGE(PG8_SB(0, 0), cB, voffB); PG8_STAGE(PG8_SB(0, 1), cB + hstepB, voffB); PG8_STAGE(PG8_SA(0, 0), cA, voffA); PG8_STAGE(PG8_SA(0, 1), cA + hstepA, voffA);
        if (wr == 1) PG8_BAR;
        PG8_WAIT_V(2); PG8_BAR;
        PG8_STAGE(PG8_SB(1, 0), cB + kstep, voffB); PG8_STAGE(PG8_SA(1, 0), cA + kstep, voffA); PG8_STAGE(PG8_SB(1, 1), cB + hstepB + kstep, voffB);
        PG8_WAIT_V(6); PG8_BAR;
    } else {
        PG8_STAGE(PG8_SB(0, 0), cB, voffB); PG8_STAGE(PG8_SA(0, 0), cA, voffA); PG8_STAGE(PG8_SB(0, 1), cB + hstepB, voffB); PG8_STAGE(PG8_SA(0, 1), cA + hstepA, voffA);
        if (wr == 1) PG8_BAR;
        PG8_WAIT_V(4); PG8_BAR;
        PG8_STAGE(PG8_SB(1, 0), cB + kstep, voffB); PG8_STAGE(PG8_SA(1, 0), cA + kstep, voffA); PG8_STAGE(PG8_SB(1, 1), cB + hstepB + kstep, voffB);
        PG8_WAIT_V(6); PG8_BAR;
    }
    for (;;) {
        const bool has_next = S.next(ui + 1, nxt);
        const char* nA = has_next ? (const char*)g.A + (size_t)nxt.pm * tstepA : cA; const char* nB = has_next ? (const char*)g.Bt + (size_t)nxt.pn * tstepB : cB;
        for (int t = 0; t < nt; t += 2) {
            const bool last = (t == nt - 2);
            const char* a1 = cA + (size_t)(t + 1) * kstep;
            const char* a2 = last ? nA : cA + (size_t)(t + 2) * kstep; const char* b2 = last ? nB : cB + (size_t)(t + 2) * kstep;
            const char* a3 = a2 + kstep; const char* b3 = b2 + kstep;
            if (last && has_next) S.a_ready(nxt);
            if constexpr (SP2) {
            PG8_LDB(B0, 0, 0); PG8_LDB(B1, 0, 1); PG8_SCHED; PG8_LDA(At, 0, 0); PG8_STAGE(PG8_SA(1, 1), a1 + hstepA, voffA);
            PG8_WAIT_V(8); PG8_WAIT_L(0); PG8_BAR; PG8_MMA(0, 0, At, B0); PG8_MMA(0, 1, At, B1); PG8_BAR; PG8_SCHED;
            PG8_LDA(At, 0, 1); PG8_STAGE(PG8_SB(0, 0), b2, voffB); PG8_STAGE(PG8_SB(0, 1), b2 + hstepB, voffB); PG8_STAGE(PG8_SA(0, 0), a2, voffA);
            PG8_WAIT_V(8); PG8_WAIT_L(0); PG8_BAR; PG8_MMA(1, 0, At, B0); PG8_MMA(1, 1, At, B1); PG8_BAR; PG8_SCHED;
            PG8_LDB(B0, 1, 0); PG8_LDB(B1, 1, 1); PG8_SCHED; PG8_LDA(At, 1, 0); PG8_STAGE(PG8_SA(0, 1), a2 + hstepA, voffA);
            PG8_WAIT_V(8); PG8_WAIT_L(0); PG8_BAR; PG8_MMA(0, 0, At, B0); PG8_MMA(0, 1, At, B1); PG8_BAR; PG8_SCHED;
            PG8_LDA(At, 1, 1); PG8_STAGE(PG8_SB(1, 0), b3, voffB); PG8_STAGE(PG8_SB(1, 1), b3 + hstepB, voffB); PG8_STAGE(PG8_SA(1, 0), a3, voffA);
            PG8_WAIT_V(8); PG8_WAIT_L(0); PG8_BAR; PG8_MMA(1, 0, At, B0); PG8_MMA(1, 1, At, B1); PG8_BAR; PG8_SCHED;
            } else {
            PG8_LDB(B0, 0, 0); PG8_SCHED; PG8_LDA(At, 0, 0); PG8_STAGE(PG8_SA(1, 1), a1 + hstepA, voffA);
            PG8_WAIT_L(8); PG8_BAR; PG8_WAIT_L(0); PG8_MMA(0, 0, At, B0); PG8_BAR; PG8_SCHED;
            PG8_LDB(B1, 0, 1); PG8_STAGE(PG8_SB(0, 0), b2, voffB);
            PG8_BAR; PG8_WAIT_L(0); PG8_MMA(0, 1, At, B1); PG8_BAR;
            PG8_LDA(At, 0, 1); PG8_STAGE(PG8_SA(0, 0), a2, voffA);
            PG8_BAR; PG8_WAIT_L(0); PG8_MMA(1, 0, At, B0); PG8_BAR; PG8_SCHED;
            PG8_STAGE(PG8_SB(0, 1), b2 + hstepB, voffB);
            PG8_WAIT_V(6); PG8_BAR; PG8_MMA(1, 1, At, B1); PG8_BAR;
            PG8_LDB(B0, 1, 0); PG8_SCHED; PG8_LDA(At, 1, 0); PG8_STAGE(PG8_SA(0, 1), a2 + hstepA, voffA);
            PG8_WAIT_L(8); PG8_BAR; PG8_WAIT_L(0); PG8_MMA(0, 0, At, B0); PG8_BAR; PG8_SCHED;
            PG8_LDB(B1, 1, 1); PG8_STAGE(PG8_SB(1, 0), b3, voffB);
            PG8_BAR; PG8_WAIT_L(0); PG8_MMA(0, 1, At, B1); PG8_BAR;
            PG8_LDA(At, 1, 1); PG8_STAGE(PG8_SA(1, 0), a3, voffA);
            PG8_BAR; PG8_WAIT_L(0); PG8_MMA(1, 0, At, B0); PG8_BAR; PG8_SCHED;
            PG8_STAGE(PG8_SB(1, 1), b3 + hstepB, voffB);
            PG8_WAIT_V(6); PG8_BAR; PG8_MMA(1, 1, At, B1); PG8_BAR;
            }
        }
        if constexpr (ALIGN_EPI) { if (wr == 0) PG8_BAR; }
        if constexpr (!Epi::AFTER_DRAIN) { E(acc, cur, wr, wc, fr, fq); S.done(cur); }
        if (!has_next) break;
#pragma unroll
        for (int a = 0; a < 2; ++a)
#pragma unroll
            for (int b = 0; b < 2; ++b)
#pragma unroll
                for (int m = 0; m < 4; ++m)
#pragma unroll
                    for (int n = 0; n < 2; ++n) acc[a][b][m][n] = (f32x4){0.f, 0.f, 0.f, 0.f};
        cur = nxt; cA = nA; cB = nB; ++ui;
        if constexpr (ALIGN_EPI) { if (wr == 1) PG8_BAR; }
    }
    PG8_WAIT_V(0);
    if constexpr (!ALIGN_EPI) { if (wr == 0) PG8_BAR; }
    PG8_BAR;
    if constexpr (Epi::AFTER_DRAIN) { E.fused(acc, cur, wr, wc, fr, fq, lds, wid, lane); S.done(cur); }
#undef PG8_SA
#undef PG8_SB
#undef PG8_STAGE
#undef PG8_LDA
#undef PG8_LDB
#undef PG8_MMA
#undef PG8_WAIT_V
#undef PG8_WAIT_L
#undef PG8_BAR
#undef PG8_SCHED
}

template <class Epi, class Sched>
__device__ __forceinline__ void gemm_naive(const Gemm g, const Sched& S, const Epi& E) {
    int tid_ = threadIdx.x; asm volatile("" : "+v"(tid_));
    const int tid = tid_, wid = __builtin_amdgcn_readfirstlane(tid >> 6), lane = tid & 63, wr = wid >> 2, wc = wid & 3, fr = lane & 15, fq = lane >> 4;
    Unit u;
    for (int ui = 0; S.next(ui, u); ++ui) {
        f32x4 acc[2][2][4][2];
#pragma unroll
        for (int a = 0; a < 2; ++a)
#pragma unroll
            for (int b = 0; b < 2; ++b)
#pragma unroll
                for (int m = 0; m < 4; ++m)
#pragma unroll
                    for (int n = 0; n < 2; ++n) acc[a][b][m][n] = (f32x4){0.f, 0.f, 0.f, 0.f};
        for (int k0 = 0; k0 < g.K; k0 += 8) {
            float af[2][4][8];
#pragma unroll
            for (int ai = 0; ai < 2; ++ai)
#pragma unroll
                for (int m = 0; m < 4; ++m) { const u32x4 v = *(const u32x4*)(g.A + (size_t)(u.pm * 256 + ai * 128 + wr * 64 + m * 16 + fr) * g.lda + k0);
                    af[ai][m][0] = bflo(v.x); af[ai][m][1] = bfhi(v.x); af[ai][m][2] = bflo(v.y); af[ai][m][3] = bfhi(v.y); af[ai][m][4] = bflo(v.z); af[ai][m][5] = bfhi(v.z); af[ai][m][6] = bflo(v.w); af[ai][m][7] = bfhi(v.w); }
#pragma unroll
            for (int bj = 0; bj < 2; ++bj)
#pragma unroll
                for (int n = 0; n < 2; ++n)
#pragma unroll
                    for (int j = 0; j < 4; ++j) {
                        const int col = u.pn * 256 + bj * 128 + wc * 32 + (Epi::PERM ? (8 * fq + 4 * n + j) : (16 * n + 4 * fq + j));
                        const u32x4 v = *(const u32x4*)(g.Bt + (size_t)col * g.K + k0);
                        const float b0 = bflo(v.x), b1 = bfhi(v.x), b2 = bflo(v.y), b3 = bfhi(v.y), b4 = bflo(v.z), b5 = bfhi(v.z), b6 = bflo(v.w), b7 = bfhi(v.w);
#pragma unroll
                        for (int ai = 0; ai < 2; ++ai)
#pragma unroll
                            for (int m = 0; m < 4; ++m) {
                                const float* a = af[ai][m];
                                acc[ai][bj][m][n][j] += ((a[0] * b0 + a[1] * b1) + (a[2] * b2 + a[3] * b3)) + ((a[4] * b4 + a[5] * b5) + (a[6] * b6 + a[7] * b7));
                            }
                    }
        }
        E(acc, u, wr, wc, fr, fq);
    }
}
}
using pg8::Unit;
typedef const f32x4 (&AccRef)[2][2][4][2];
__device__ __forceinline__ void load_rstd(float (&rs)[2][4], const float* stats, const Unit& u, int wr, int fr, int fq) {
#pragma unroll
    for (int ai = 0; ai < 2; ++ai)
#pragma unroll
        for (int m = 0; m < 4; ++m) {
            const int row = u.pm * 256 + ai * 128 + wr * 64 + m * 16 + fr;
            const f32x4 v = *(const GAS f32x4*)(stats + (size_t)row * 16 + 4 * fq);
            float s = (v.x + v.y) + (v.z + v.w); s += __shfl_xor(s, 16); s += __shfl_xor(s, 32);
            rs[ai][m] = rsqrtf(s * (1.0f / DM) + EPS);
        }
}
__device__ __forceinline__ u32x4 pack8(const f32x4 a, const f32x4 b) { u32x4 w; w.x = cvt_pk(a[0], a[1]); w.y = cvt_pk(a[2], a[3]); w.z = cvt_pk(b[0], b[1]); w.w = cvt_pk(b[2], b[3]); return w; }

struct EpiSwiglu {
    static constexpr bool PERM = true, AFTER_DRAIN = false;
    bf16_t* out; const float* stats;
    __device__ __forceinline__ void operator()(AccRef acc, const Unit& u, int wr, int wc, int fr, int fq) const {
        float rs[2][4]; load_rstd(rs, stats, u, wr, fr, fq);
#pragma unroll
        for (int ai = 0; ai < 2; ++ai)
#pragma unroll
            for (int m = 0; m < 4; ++m) { asm volatile("" ::: "memory");
                const int row = u.pm * 256 + ai * 128 + wr * 64 + m * 16 + fr; const float r = rs[ai][m];
                f32x4 o[2];
#pragma unroll
                for (int n = 0; n < 2; ++n)
#pragma unroll
                    for (int j = 0; j < 4; ++j) { const float v1 = acc[ai][0][m][n][j] * r, v3 = acc[ai][1][m][n][j] * r; o[n][j] = v1 * fsigmoid(v1) * v3; }
                *(GAS u32x4*)(out + (size_t)row * FF + u.pn * 128 + wc * 32 + 8 * fq) = pack8(o[0], o[1]);
            }
    }
};
template <bool GATE> struct EpiResid {
    static constexpr bool PERM = true, AFTER_DRAIN = false;
    const bf16_t* res; bf16_t* hb; float* stats_out; float alpha; const float* stats_in; const bf16_t* pe;
    __device__ __forceinline__ void operator()(AccRef acc, const Unit& u, int wr, int wc, int fr, int fq) const {
        float rs[2][4];
        if (GATE) load_rstd(rs, stats_in, u, wr, fr, fq);
        constexpr int MB = GATE ? 1 : 2;
#pragma unroll
        for (int ag = 0; ag < 8 / MB; ++ag) { const int ai = (ag * MB) >> 2, m0 = (ag * MB) & 3;
            u32x4 rw[4][2], pw[4][2];
            asm volatile("" ::: "memory");
#pragma unroll
            for (int m = m0; m < m0 + MB; ++m)
#pragma unroll
                for (int bj = 0; bj < 2; ++bj) {
                    const size_t off = (size_t)(u.pm * 256 + ai * 128 + wr * 64 + m * 16 + fr) * DM + u.pn * 256 + bj * 128 + wc * 32 + 8 * fq;
                    rw[m][bj] = *(const GAS u32x4*)(res + off);
                    if (GATE) pw[m][bj] = *(const GAS u32x4*)(pe + off);
                }
            asm volatile("" ::: "memory");
#pragma unroll
            for (int m = m0; m < m0 + MB; ++m) {
                const int row = u.pm * 256 + ai * 128 + wr * 64 + m * 16 + fr; float ss = 0.f;
#pragma unroll
                for (int bj = 0; bj < 2; ++bj) {
                    const size_t off = (size_t)row * DM + u.pn * 256 + bj * 128 + wc * 32 + 8 * fq;
                    f32x4 v0 = acc[ai][bj][m][0], v1 = acc[ai][bj][m][1];
                    if (GATE) { const u32x4 p = pw[m][bj]; const float r = rs[ai][m];
                        v0[0] = fsigmoid(v0[0] * r) * bflo(p.x); v0[1] = fsigmoid(v0[1] * r) * bfhi(p.x); v0[2] = fsigmoid(v0[2] * r) * bflo(p.y); v0[3] = fsigmoid(v0[3] * r) * bfhi(p.y);
                        v1[0] = fsigmoid(v1[0] * r) * bflo(p.z); v1[1] = fsigmoid(v1[1] * r) * bfhi(p.z); v1[2] = fsigmoid(v1[2] * r) * bflo(p.w); v1[3] = fsigmoid(v1[3] * r) * bfhi(p.w); }
                    const u32x4 w = rw[m][bj];
                    const f32x4 r0 = (f32x4){bflo(w.x), bfhi(w.x), bflo(w.y), bfhi(w.y)}, r1 = (f32x4){bflo(w.z), bfhi(w.z), bflo(w.w), bfhi(w.w)};
                    const f32x4 h0 = r0 + alpha * v0, h1 = r1 + alpha * v1;
                    *(GAS u32x4*)(hb + off) = pack8(h0, h1);
                    ss += (h0[0] * h0[0] + h0[1] * h0[1]) + (h0[2] * h0[2] + h0[3] * h0[3]) + (h1[0] * h1[0] + h1[1] * h1[1]) + (h1[2] * h1[2] + h1[3] * h1[3]);
                }
                ss += __shfl_xor(ss, 16); ss += __shfl_xor(ss, 32);
                if (fq == 0) ((GAS float*)stats_out)[(size_t)row * 16 + u.pn * 4 + wc] = ss;
            }
        }
    }
};
struct EpiInproj {
    static constexpr bool PERM = true, AFTER_DRAIN = false;
    bf16_t* zA; bf16_t* qB; const float* stats; float* ps;
    __device__ __forceinline__ void operator()(AccRef acc, const Unit& u, int wr, int wc, int fr, int fq) const {
        float rs[2][4]; load_rstd(rs, stats, u, wr, fr, fq);
        bf16_t* base; int pitch;
        if (u.pn < 3) { base = zA + 256 * u.pn; pitch = 768; } else { const int k = (u.pn - 3) >> 1; base = qB + (size_t)k * (16 * MiB / 2) + 256 * ((u.pn - 3) & 1); pitch = 512; }
#pragma unroll
        for (int ai = 0; ai < 2; ++ai)
#pragma unroll
            for (int m = 0; m < 4; ++m) { asm volatile("" ::: "memory");
                const int row = u.pm * 256 + ai * 128 + wr * 64 + m * 16 + fr; const float r = rs[ai][m];
                float ss = 0.f;
#pragma unroll
                for (int bj = 0; bj < 2; ++bj) { const f32x4 v0 = acc[ai][bj][m][0] * r, v1 = acc[ai][bj][m][1] * r;
                    *(GAS u32x4*)(base + (size_t)row * pitch + bj * 128 + wc * 32 + 8 * fq) = pack8(v0, v1);
                    if (bj == 0 || u.pn != 1) ss += (v0[0] * v0[0] + v0[1] * v0[1]) + (v0[2] * v0[2] + v0[3] * v0[3]) + (v1[0] * v1[0] + v1[1] * v1[1]) + (v1[2] * v1[2] + v1[3] * v1[3]); }
                if (u.pn < 3) { ss += __shfl_xor(ss, 16); ss += __shfl_xor(ss, 32); if (fq == 0) ((GAS float*)ps)[(size_t)row * 12 + 4 * u.pn + wc] = ss; }
            }
    }
};
struct EpiGates {
    static constexpr bool PERM = true, AFTER_DRAIN = false;
    bf16_t* X; const float* stats;
    __device__ __forceinline__ void operator()(AccRef acc, const Unit& u, int wr, int wc, int fr, int fq) const {
        float rs[2][4]; load_rstd(rs, stats, u, wr, fr, fq);
#pragma unroll
        for (int ai = 0; ai < 2; ++ai)
#pragma unroll
            for (int m = 0; m < 4; ++m) { asm volatile("" ::: "memory");
                const int row = u.pm * 256 + ai * 128 + wr * 64 + m * 16 + fr; const float r = rs[ai][m];
#pragma unroll
                for (int bj = 0; bj < 2; ++bj) { f32x4 a = acc[ai][bj][m][0], b = acc[ai][bj][m][1];
#pragma unroll
                    for (int j = 0; j < 4; ++j) { a[j] = fsigmoid(a[j] * r); b[j] = fsigmoid(b[j] * r); }
                    *(GAS u32x4*)(X + (size_t)row * 3072 + u.pn * 256 + bj * 128 + wc * 32 + 8 * fq) = pack8(a, b); }
            }
    }
};
struct EpiMulGate {
    static constexpr bool PERM = true, AFTER_DRAIN = false;
    bf16_t* X; int br;
    __device__ __forceinline__ void operator()(AccRef acc, const Unit& u, int wr, int wc, int fr, int fq) const {
#pragma unroll
        for (int ai = 0; ai < 2; ++ai)
#pragma unroll
            for (int m = 0; m < 4; ++m) { asm volatile("" ::: "memory");
                const int row = u.pm * 256 + ai * 128 + wr * 64 + m * 16 + fr;
#pragma unroll
                for (int bj = 0; bj < 2; ++bj) { bf16_t* p = X + (size_t)row * 3072 + br * 1024 + u.pn * 256 + bj * 128 + wc * 32 + 8 * fq;
                    const u32x4 g = *(const GAS u32x4*)p; f32x4 a = acc[ai][bj][m][0], b = acc[ai][bj][m][1];
                    a[0] *= bflo(g.x); a[1] *= bfhi(g.x); a[2] *= bflo(g.y); a[3] *= bfhi(g.y); b[0] *= bflo(g.z); b[1] *= bfhi(g.z); b[2] *= bflo(g.w); b[3] *= bfhi(g.w);
                    *(GAS u32x4*)p = pack8(a, b); }
            }
    }
};
struct EpiStore {
    static constexpr bool PERM = true, AFTER_DRAIN = false;
    bf16_t* out; int pitch; const float* rowscale; int mode;
    __device__ __forceinline__ void operator()(AccRef acc, const Unit& u, int wr, int wc, int fr, int fq) const {
#pragma unroll
        for (int ai = 0; ai < 2; ++ai)
#pragma unroll
            for (int m = 0; m < 4; ++m) { asm volatile("" ::: "memory");
                const int row = u.pm * 256 + ai * 128 + wr * 64 + m * 16 + fr; float r = 1.0f;
                if (rowscale) { const GAS f32x4* pp = (const GAS f32x4*)(rowscale + (size_t)row * 12);
                    if (mode == 1) { const f32x4 a = pp[0], b = pp[1]; r = rsqrtf((((a[0] + a[1]) + (a[2] + a[3])) + ((b[0] + b[1]) + (b[2] + b[3]))) * (1.0f / 384.0f) + EPS); }
                    else { const f32x4 a = pp[2]; r = rsqrtf(((a[0] + a[1]) + (a[2] + a[3])) * (1.0f / 256.0f) + EPS); } }
#pragma unroll
                for (int bj = 0; bj < 2; ++bj) *(GAS u32x4*)(out + (size_t)row * pitch + u.pn * 256 + bj * 128 + wc * 32 + 8 * fq) = pack8(acc[ai][bj][m][0] * r, acc[ai][bj][m][1] * r);
            }
    }
};
struct EpiMulGateAcc {
    static constexpr bool PERM = true, AFTER_DRAIN = false;
    const bf16_t* X; bf16_t* Xm; int br;
    __device__ __forceinline__ void operator()(AccRef acc, const Unit& u, int wr, int wc, int fr, int fq) const {
#pragma unroll
        for (int ag = 0; ag < 4; ++ag) { const int ai = ag >> 1, m0 = 2 * (ag & 1);
            u32x4 gw[4][2], qw[4][2];
            asm volatile("" ::: "memory");
#pragma unroll
            for (int m = m0; m < m0 + 2; ++m)
#pragma unroll
                for (int bj = 0; bj < 2; ++bj) {
                    const int row = u.pm * 256 + ai * 128 + wr * 64 + m * 16 + fr, col = u.pn * 256 + bj * 128 + wc * 32 + 8 * fq;
                    gw[m][bj] = *(const GAS u32x4*)(X + (size_t)row * 3072 + br * 1024 + col);
                    qw[m][bj] = (br > 0) ? *(const GAS u32x4*)(Xm + (size_t)row * DM + col) : (u32x4){0u, 0u, 0u, 0u};
                }
            asm volatile("" ::: "memory");
#pragma unroll
            for (int m = m0; m < m0 + 2; ++m) {
                const int row = u.pm * 256 + ai * 128 + wr * 64 + m * 16 + fr;
#pragma unroll
                for (int bj = 0; bj < 2; ++bj) { const int col = u.pn * 256 + bj * 128 + wc * 32 + 8 * fq;
                    const u32x4 g = gw[m][bj], q = qw[m][bj];
                    f32x4 a = acc[ai][bj][m][0], b = acc[ai][bj][m][1];
                    a[0] = a[0] * bflo(g.x) + bflo(q.x); a[1] = a[1] * bfhi(g.x) + bfhi(q.x); a[2] = a[2] * bflo(g.y) + bflo(q.y); a[3] = a[3] * bfhi(g.y) + bfhi(q.y);
                    b[0] = b[0] * bflo(g.z) + bflo(q.z); b[1] = b[1] * bfhi(g.z) + bfhi(q.z); b[2] = b[2] * bflo(g.w) + bflo(q.w); b[3] = b[3] * bfhi(g.w) + bfhi(q.w);
                    *(GAS u32x4*)(Xm + (size_t)row * DM + col) = pack8(a, b); }
            }
        }
    }
};
struct WSP {
    unsigned* ctl; f32x2* rope; float* stats0; float* stats1; float* statq; bf16_t* WB;
    bf16_t *HB, *HB2, *PBF, *zA, *qM, *qB, *qC, *kB, *vB, *kC, *vC, *kvM, *X, *FFH, *PE, *Xm;
};
template <int MODE> struct ACfg;
template <> struct ACfg<0> { static constexpr int DQK = 96, DV = 64, KP = 208, VP = 192; };
template <> struct ACfg<1> { static constexpr int DQK = 64, DV = 128, KP = 144, VP = 320; };
template <> struct ACfg<2> { static constexpr int DQK = 64, DV = 64, KP = 144, VP = 192; };
constexpr int A_KOFF = 0, A_VOFF = 32768, A_FLAG = 73728, A_IDX = 73728 + 64, A_XCH = 73728 + 128;
__device__ __forceinline__ int crow(int r, int hi) { return (r & 3) + 8 * (r >> 2) + 4 * hi; }
__device__ __forceinline__ float pmax32(float v) { const auto rr = __builtin_amdgcn_permlane32_swap(__float_as_uint(v), __float_as_uint(v), false, false); return fmaxf(__uint_as_float(rr[0]), __uint_as_float(rr[1])); }
__device__ __forceinline__ float psum32(float v) { const auto rr = __builtin_amdgcn_permlane32_swap(__float_as_uint(v), __float_as_uint(v), false, false); return __uint_as_float(rr[0]) + __uint_as_float(rr[1]); }
__device__ __forceinline__ float diff_lambda(const float* const* in, int layer) {
    const float* q1 = in[12] + layer * 64; const float* k1 = in[13] + layer * 64; const float* q2 = in[14] + layer * 64; const float* k2 = in[15] + layer * 64;
    float s1 = 0.f, s2 = 0.f;
    for (int i = 0; i < 64; ++i) { s1 += q1[i] * k1[i]; s2 += q2[i] * k2[i]; }
    const float li = layer == 0 ? 0.2f : 0.35550906759f;
    return expf(s1) - expf(s2) + li;
}

template <int MODE>
__device__ __forceinline__ void attn_unit(const WSP& W, const float* const* in, int layer, int b, int h, int qb, LAS unsigned char* lds) {
    using C = ACfg<MODE>;
    constexpr int DQK = C::DQK, DV = C::DV, KP = C::KP, VP = C::VP, NS = DQK / 16, ND = DV / 32, CHK = DQK / 8, CHV = DV / 8;
    constexpr int KBUF = 64 * KP, VBUF = 64 * VP;
    int tid_ = threadIdx.x; asm volatile("" : "+v"(tid_));
    const int tid = tid_, lane = tid & 63, wid = __builtin_amdgcn_readfirstlane(tid >> 6), r32 = lane & 31, hi = lane >> 5;
    const size_t rowbase = (size_t)b * SEQ; const int q0 = qb * 256, NT = 4 * (qb + 1);
    const int qpos = q0 + wid * 32 + r32;
    const int wq_lo = q0 + wid * 32, wq_hi = wq_lo + 31;
    constexpr int NPASS = (MODE == 1) ? 2 : 1;
    unsigned osave[ND][8];
    float slope2 = 0.f;
    if (MODE == 1) slope2 = exp2f(-2.0f * (float)(h + 1)) * LOG2E;
    const int koff = r32 * KP + hi * 16;
    const int voff = (4 * hi + ((lane & 15) >> 2)) * VP + (((lane >> 4) & 1) * 16 + (lane & 3) * 4) * 2;
    f32x16 o[ND];
    float l_run = 0.f;
#pragma unroll 1
    for (int pass = 0; pass < NPASS; ++pass) {
        const bf16_t *Qrow, *K1, *K2 = nullptr, *V; int k1p, k2p = 0, vp;
        if (MODE == 0) { Qrow = W.qM + (rowbase + qpos) * 768; K1 = W.kvM + rowbase * 1024 + 64 * h; k1p = 1024; K2 = W.zA + rowbase * 768 + 384; k2p = 768; V = W.kvM + rowbase * 1024 + 512 + 64 * h; vp = 1024; }
        else if (MODE == 1) { Qrow = W.qB + (rowbase + qpos) * 512 + 128 * h + 64 * pass; K1 = W.kB + rowbase * 512 + 128 * h + 64 * pass; k1p = 512; V = W.vB + rowbase * 512 + 128 * h; vp = 512; }
        else { Qrow = W.qC + (rowbase + qpos) * 512 + 64 * h; K1 = W.kC + rowbase * 512 + 64 * h; k1p = 512; V = W.vC + rowbase * 512 + 64 * h; vp = 512; }
        bf16x8 qf[NS];
#pragma unroll
        for (int s = 0; s < NS; ++s) {
            if (MODE == 0) qf[s] = (s < 4) ? *(const GAS bf16x8*)(Qrow + 64 * h + 16 * s + 8 * hi) : *(const GAS bf16x8*)(Qrow + 512 + 32 * h + 16 * (s - 4) + 8 * hi);
            else qf[s] = *(const GAS bf16x8*)(Qrow + 16 * s + 8 * hi);
        }
        if (MODE == 0) {
            const GAS f32x4* tp = (const GAS f32x4*)(W.rope + (size_t)qpos * 16 + 8 * hi);
            u32x4 a = __builtin_bit_cast(u32x4, qf[NS - 2]), c = __builtin_bit_cast(u32x4, qf[NS - 1]);
#pragma unroll
            for (int i = 0; i < 4; ++i) { const f32x4 cs = tp[i];
                const float x1l = bflo(a[i]), x1h = bfhi(a[i]), x2l = bflo(c[i]), x2h = bfhi(c[i]);
                a[i] = cvt_pk(x1l * cs[0] - x2l * cs[1], x1h * cs[2] - x2h * cs[3]); c[i] = cvt_pk(x2l * cs[0] + x1l * cs[1], x2h * cs[2] + x1h * cs[3]); }
            qf[NS - 2] = __builtin_bit_cast(bf16x8, a); qf[NS - 1] = __builtin_bit_cast(bf16x8, c);
        }
#pragma unroll
        for (int d = 0; d < ND; ++d) o[d] = (f32x16){};
        float m_run = -1e30f; l_run = 0.f;
        float carry = 1.0f;
        u32x4 kst[2], vst[2], kst2[2], vst2[2];
        const int kkey0 = tid / CHK, kch0 = tid % CHK, kkey1 = (tid + 512) / CHK, kch1 = (tid + 512) % CHK;
        const int vkey0 = tid / CHV, vch0 = tid % CHV, vkey1 = (tid + 512) / CHV, vch1 = (tid + 512) % CHV;
        constexpr bool K2ND = (64 * CHK > 512), V2ND = (64 * CHV > 512);
        const bool k2nd = K2ND && (tid + 512 < 64 * CHK);
#define ATT_KSRC(key, ch) ((MODE == 0 && (ch) >= 8) ? (K2 + (size_t)(key) * k2p + 8 * ((ch) - 8)) : (K1 + (size_t)(key) * k1p + 8 * (ch)))
#define ATT_LOAD(kt_) do { const int key0_ = 64 * (kt_); \
            kst[0] = *(const GAS u32x4*)ATT_KSRC(key0_ + kkey0, kch0); if (k2nd) kst[1] = *(const GAS u32x4*)ATT_KSRC(key0_ + kkey1, kch1); \
            vst[0] = *(const GAS u32x4*)(V + (size_t)(key0_ + vkey0) * vp + 8 * vch0); if (V2ND) vst[1] = *(const GAS u32x4*)(V + (size_t)(key0_ + vkey1) * vp + 8 * vch1); } while (0)
#define ATT_LOAD2(kt_) do { const int key0_ = 64 * (kt_); \
            kst2[0] = *(const GAS u32x4*)ATT_KSRC(key0_ + kkey0, kch0); if (k2nd) kst2[1] = *(const GAS u32x4*)ATT_KSRC(key0_ + kkey1, kch1); \
            vst2[0] = *(const GAS u32x4*)(V + (size_t)(key0_ + vkey0) * vp + 8 * vch0); if (V2ND) vst2[1] = *(const GAS u32x4*)(V + (size_t)(key0_ + vkey1) * vp + 8 * vch1); } while (0)
#define ATT_STORE(buf_) do { LAS unsigned char* kb_ = lds + A_KOFF + (buf_) * KBUF; LAS unsigned char* vb_ = lds + A_VOFF + (buf_) * VBUF; \
            *(LAS u32x4*)(kb_ + kkey0 * KP + kch0 * 16) = kst[0]; if (k2nd) *(LAS u32x4*)(kb_ + kkey1 * KP + kch1 * 16) = kst[1]; \
            *(LAS u32x4*)(vb_ + vkey0 * VP + vch0 * 16) = vst[0]; if (V2ND) *(LAS u32x4*)(vb_ + vkey1 * VP + vch1 * 16) = vst[1]; } while (0)
        __syncthreads();
        ATT_LOAD(MODE == 2 ? NT - 1 : 0); ATT_STORE(0);
        constexpr bool DEFER = (MODE != 1);
        if (DEFER) ATT_LOAD(MODE == 2 ? NT - 2 : 1);
        __syncthreads();
#pragma unroll 1
        for (int t = 0; t < NT; ++t) {
            const int kt = (MODE == 2) ? (NT - 1 - t) : t;
            const bool more = (t + 1 < NT);
            if (DEFER) { if (t + 2 < NT) ATT_LOAD2(MODE == 2 ? kt - 2 : kt + 2); } else { if (more) ATT_LOAD(MODE == 2 ? kt - 1 : kt + 1); }
            const int key0 = 64 * kt;
            const bool band = (kt >= NT - 4);
            bool active = (key0 <= wq_hi);
            bool alive = true;
            if (MODE == 2) { alive = __any(carry != 0.0f); active = active && alive; }
            if (active) {
                LAS unsigned char* kb = lds + A_KOFF + (t & 1) * KBUF + koff;
                LAS unsigned char* vb = lds + A_VOFF + (t & 1) * VBUF + voff;
                f32x16 s0, s1;
                if (MODE == 1) {
                    const float t1 = slope2 * (float)(key0 + 4 * hi - qpos);
#pragma unroll
                    for (int r = 0; r < 16; ++r) { const float c = (float)((r & 3) + 8 * (r >> 2)); s0[r] = fmaf(slope2, c, t1); s1[r] = fmaf(slope2, c + 32.0f, t1); }
                } else { s0 = (f32x16){}; s1 = (f32x16){}; }
#pragma unroll
                for (int s = 0; s < NS; ++s) {
                    const bf16x8 k0 = *(const LAS bf16x8*)(kb + s * 32), k1 = *(const LAS bf16x8*)(kb + 32 * KP + s * 32);
                    s0 = __builtin_amdgcn_mfma_f32_32x32x16_bf16(k0, qf[s], s0, 0, 0, 0);
                    s1 = __builtin_amdgcn_mfma_f32_32x32x16_bf16(k1, qf[s], s1, 0, 0, 0);
                }
                if (MODE != 2) {
                    if (band) {
                        asm volatile("" ::: "memory");
#pragma unroll
                        for (int r = 0; r < 16; ++r) { const int key = key0 + crow(r, hi); if (key > qpos) s0[r] = -INFINITY; if (key + 32 > qpos) s1[r] = -INFINITY; }
                    }
                    float mx = fmaxf(s0[0], s1[0]);
#pragma unroll
                    for (int r = 1; r < 16; ++r) mx = fmaxf(mx, fmaxf(s0[r], s1[r]));
                    mx = pmax32(mx);
                    const float m_new = fmaxf(m_run, mx);
                    const float alpha = __builtin_amdgcn_exp2f(m_run - m_new);
                    m_run = m_new;
                    float ps = 0.f;
#pragma unroll
                    for (int r = 0; r < 16; ++r) { s0[r] = __builtin_amdgcn_exp2f(s0[r] - m_new); s1[r] = __builtin_amdgcn_exp2f(s1[r] - m_new); ps += s0[r] + s1[r]; }
                    l_run = l_run * alpha + ps;
#pragma unroll
                    for (int d = 0; d < ND; ++d) o[d] *= alpha;
                } else {
#pragma unroll
                    for (int r = 0; r < 16; ++r) {
                        float e0 = __builtin_amdgcn_exp2f(s0[r]), e1 = __builtin_amdgcn_exp2f(s1[r]);
                        float m0 = __builtin_amdgcn_rcpf(1.0f + e0), m1 = __builtin_amdgcn_rcpf(1.0f + e1);
                        s0[r] = m0; s1[r] = m1;
                    }
                    if (band) {
                        asm volatile("" ::: "memory");
#pragma unroll
                        for (int r = 0; r < 16; ++r) { const int key = key0 + crow(r, hi); if (key >= qpos) s0[r] = 1.0f; if (key + 32 >= qpos) s1[r] = 1.0f; }
                    }
                    float gp[8];
#pragma unroll
                    for (int a = 0; a < 8; ++a) {
                        const int rb = 4 * (a & 3);
                        float x0, x1, x2, x3;
                        if (a < 4) { x0 = s0[rb]; x1 = s0[rb + 1]; x2 = s0[rb + 2]; x3 = s0[rb + 3]; } else { x0 = s1[rb]; x1 = s1[rb + 1]; x2 = s1[rb + 2]; x3 = s1[rb + 3]; }
                        const float e2 = x3, e1 = e2 * x2, e0 = e1 * x1;
                        gp[a] = e0 * x0;
                        const float w3 = (1.0f - x3), w2 = (1.0f - x2) * e2, w1 = (1.0f - x1) * e1, w0 = (1.0f - x0) * e0;
                        if (a < 4) { s0[rb] = w0; s0[rb + 1] = w1; s0[rb + 2] = w2; s0[rb + 3] = w3; } else { s1[rb] = w0; s1[rb + 1] = w1; s1[rb + 2] = w2; s1[rb + 3] = w3; }
                    }
                    float f = carry;
#pragma unroll
                    for (int a = 7; a >= 0; --a) {
                        const int rb = 4 * (a & 3);
                        const auto rr_ = __builtin_amdgcn_permlane32_swap(__float_as_uint(gp[a]), __float_as_uint(gp[a]), false, false);
                        const float g_lo = __uint_as_float(rr_[0]), g_hi = __uint_as_float(rr_[1]);
                        const float fac = (hi == 0) ? f * g_hi : f;
                        if (a < 4) { s0[rb] *= fac; s0[rb + 1] *= fac; s0[rb + 2] *= fac; s0[rb + 3] *= fac; } else { s1[rb] *= fac; s1[rb + 1] *= fac; s1[rb + 2] *= fac; s1[rb + 3] *= fac; }
                        f *= g_lo * g_hi;
                    }
                    carry = f;
                }
#pragma unroll
                for (int g = 0; g < 4; ++g) {
                    const int rb = 8 * (g & 1);
                    u32x4 pw;
                    if (g < 2) { pw.x = cvt_pk(s0[rb], s0[rb + 1]); pw.y = cvt_pk(s0[rb + 2], s0[rb + 3]); pw.z = cvt_pk(s0[rb + 4], s0[rb + 5]); pw.w = cvt_pk(s0[rb + 6], s0[rb + 7]); }
                    else { pw.x = cvt_pk(s1[rb], s1[rb + 1]); pw.y = cvt_pk(s1[rb + 2], s1[rb + 3]); pw.z = cvt_pk(s1[rb + 4], s1[rb + 5]); pw.w = cvt_pk(s1[rb + 6], s1[rb + 7]); }
                    const bf16x8 pf = __builtin_bit_cast(bf16x8, pw);
#pragma unroll
                    for (int d = 0; d < ND; ++d) {
                        const v4i16_t lo = __builtin_amdgcn_ds_read_tr16_b64_v4i16((LAS v4i16_t*)(vb + g * 16 * VP + d * 64));
                        const v4i16_t hh = __builtin_amdgcn_ds_read_tr16_b64_v4i16((LAS v4i16_t*)(vb + g * 16 * VP + 8 * VP + d * 64));
                        const bf16x8 vf = (bf16x8){lo[0], lo[1], lo[2], lo[3], hh[0], hh[1], hh[2], hh[3]};
                        o[d] = __builtin_amdgcn_mfma_f32_32x32x16_bf16(vf, pf, o[d], 0, 0, 0);
                    }
                }
            }
            if (MODE == 2) { const bool alive2 = alive && __any(carry != 0.0f); if (lane == 0) *(volatile LAS unsigned*)(lds + A_FLAG + ((t & 1) * 8 + wid) * 4) = alive2 ? 1u : 0u; }
            if (more) ATT_STORE((t + 1) & 1);
            if (DEFER) { kst[0] = kst2[0]; kst[1] = kst2[1]; vst[0] = vst2[0]; vst[1] = vst2[1]; }
            __syncthreads();
            if (MODE == 2) {
                unsigned any = 0;
#pragma unroll
                for (int w = 0; w < 8; ++w) any |= *(volatile LAS unsigned*)(lds + A_FLAG + ((t & 1) * 8 + w) * 4);
                if (any == 0) break;
            }
        }
#undef ATT_KSRC
#undef ATT_LOAD
#undef ATT_LOAD2
#undef ATT_STORE
        if (MODE == 1 && pass == 0) {
            const float inv = 1.0f / psum32(l_run);
#pragma unroll
            for (int d = 0; d < ND; ++d)
#pragma unroll
                for (int r = 0; r < 8; ++r) osave[d][r] = cvt_pk(o[d][2 * r] * inv, o[d][2 * r + 1] * inv);
        }
    }
    bf16_t* Orow;
    if (MODE == 0) Orow = W.qM + (rowbase + qpos) * 768 + 64 * h;
    else if (MODE == 1) Orow = W.qB + (rowbase + qpos) * 512 + 128 * h;
    else Orow = W.qC + (rowbase + qpos) * 512 + 64 * h;
    if (MODE == 0) {
        const float inv = 1.0f / psum32(l_run);
#pragma unroll
        for (int d = 0; d < ND; ++d) o[d] *= inv;
    } else if (MODE == 1) {
        const float lam = diff_lambda(in, layer);
        const float inv = 1.0f / psum32(l_run);
        float ss = 0.f;
#pragma unroll
        for (int d = 0; d < ND; ++d)
#pragma unroll
            for (int r = 0; r < 16; ++r) { const float y = ((r & 1) ? bfhi(osave[d][r >> 1]) : bflo(osave[d][r >> 1])) - lam * (o[d][r] * inv); o[d][r] = y; ss += y * y; }
        ss = psum32(ss);
        const float li = layer == 0 ? 0.2f : 0.35550906759f;
        const float rs = rsqrtf(ss * (1.0f / 128.0f) + EPS) * (1.0f - li);
        const float* gs = in[16] + layer * 128;
#pragma unroll
        for (int d = 0; d < ND; ++d)
#pragma unroll
            for (int j = 0; j < 4; ++j) { const f32x4 gv = *(const GAS f32x4*)(gs + 32 * d + 8 * j + 4 * hi);
#pragma unroll
                for (int i = 0; i < 4; ++i) o[d][4 * j + i] *= rs * gv[i]; }
    }
#pragma unroll
    for (int d = 0; d < ND; ++d)
#pragma unroll
        for (int j = 0; j < 4; ++j) { u32x2 w; w.x = cvt_pk(o[d][4 * j], o[d][4 * j + 1]); w.y = cvt_pk(o[d][4 * j + 2], o[d][4 * j + 3]); *(GAS u32x2*)(Orow + 32 * d + 8 * j + 4 * hi) = w; }
}

template <int MODE>
__device__ __forceinline__ void attn_unit_naive(const WSP& W, const float* const* in, int layer, int b, int h, int qb, LAS unsigned char* lds) {
    int tid_ = threadIdx.x; asm volatile("" : "+v"(tid_)); const int tid = tid_; const size_t rowbase = (size_t)b * SEQ; const int q0 = qb * 256;
    if (MODE == 0) {
        if (tid < 256) {
            const int qpos = q0 + tid; const bf16_t* Qrow = W.qM + (rowbase + qpos) * 768;
            float q[96], acc[64];
#pragma unroll
            for (int d = 0; d < 64; ++d) { q[d] = bf2f(Qrow[64 * h + d]); acc[d] = 0.f; }
#pragma unroll
            for (int d = 0; d < 16; ++d) { const float x1 = bf2f(Qrow[512 + 32 * h + d]), x2 = bf2f(Qrow[512 + 32 * h + 16 + d]); const f32x2 cs = W.rope[(size_t)qpos * 16 + d];
                q[64 + d] = bf2f((bf16_t)(cvt_pk(x1 * cs.x - x2 * cs.y, 0.f) & 0xffffu)); q[80 + d] = bf2f((bf16_t)(cvt_pk(x2 * cs.x + x1 * cs.y, 0.f) & 0xffffu)); }
            float m = -1e30f, l = 0.f;
            for (int key = 0; key <= qpos; ++key) {
                const bf16_t* kp = W.kvM + (rowbase + key) * 1024 + 64 * h; const bf16_t* kr = W.zA + (rowbase + key) * 768 + 384; const bf16_t* vp = kp + 512;
                float s = 0.f;
#pragma unroll
                for (int d = 0; d < 64; ++d) s += q[d] * bf2f(kp[d]);
#pragma unroll
                for (int d = 0; d < 32; ++d) s += q[64 + d] * bf2f(kr[d]);
                const float mn = fmaxf(m, s), al = exp2f(m - mn), p = exp2f(s - mn); m = mn; l = l * al + p;
#pragma unroll
                for (int d = 0; d < 64; ++d) acc[d] = acc[d] * al + p * bf2f(vp[d]);
            }
            const float inv = 1.0f / l; bf16_t* O = W.qM + (rowbase + qpos) * 768 + 64 * h;
#pragma unroll
            for (int d = 0; d < 64; d += 2) *(unsigned*)(O + d) = cvt_pk(acc[d] * inv, acc[d + 1] * inv);
        }
    } else if (MODE == 2) {
        if (tid < 256) {
            const int qpos = q0 + tid; const bf16_t* Qrow = W.qC + (rowbase + qpos) * 512 + 64 * h;
            float q[64], acc[64];
#pragma unroll
            for (int d = 0; d < 64; ++d) { q[d] = bf2f(Qrow[d]); acc[d] = 0.f; }
            float run = 0.f;
            for (int key = qpos - 1; key >= 0; --key) {
                const bf16_t* kp = W.kC + (rowbase + key) * 512 + 64 * h; const bf16_t* vp = W.vC + (rowbase + key) * 512 + 64 * h;
                float s = 0.f;
#pragma unroll
                for (int d = 0; d < 64; ++d) s += q[d] * bf2f(kp[d]);
                const float z = s * LN2;
                const float sp = fmaxf(z, 0.f) + log1pf(expf(-fabsf(z)));
                const float w = expf((z - sp) + run);
                run -= sp;
#pragma unroll
                for (int d = 0; d < 64; ++d) acc[d] += w * bf2f(vp[d]);
            }
            bf16_t* O = W.qC + (rowbase + qpos) * 512 + 64 * h;
#pragma unroll
            for (int d = 0; d < 64; d += 2) *(unsigned*)(O + d) = cvt_pk(acc[d], acc[d + 1]);
        }
    } else {
        const int row = tid & 255, dh = tid >> 8; const int qpos = q0 + row;
        const float slope2 = exp2f(-2.0f * (float)(h + 1)) * LOG2E;
        float y[64];
#pragma unroll 1
        for (int pass = 0; pass < 2; ++pass) {
            const bf16_t* Qrow = W.qB + (rowbase + qpos) * 512 + 128 * h + 64 * pass;
            float q[64], acc[64];
#pragma unroll
            for (int d = 0; d < 64; ++d) { q[d] = bf2f(Qrow[d]); acc[d] = 0.f; }
            float m = -1e30f, l = 0.f;
            for (int key = 0; key <= qpos; ++key) {
                const bf16_t* kp = W.kB + (rowbase + key) * 512 + 128 * h + 64 * pass; const bf16_t* vp = W.vB + (rowbase + key) * 512 + 128 * h + 64 * dh;
                float s = slope2 * (float)(key - qpos);
#pragma unroll
                for (int d = 0; d < 64; ++d) s += q[d] * bf2f(kp[d]);
                const float mn = fmaxf(m, s), al = exp2f(m - mn), p = exp2f(s - mn); m = mn; l = l * al + p;
#pragma unroll
                for (int d = 0; d < 64; ++d) acc[d] = acc[d] * al + p * bf2f(vp[d]);
            }
            const float inv = 1.0f / l;
            if (pass == 0) {
#pragma unroll
                for (int d = 0; d < 64; ++d) y[d] = acc[d] * inv;
            } else {
                const float lam = diff_lambda(in, layer);
#pragma unroll
                for (int d = 0; d < 64; ++d) y[d] -= lam * acc[d] * inv;
            }
        }
        float ss = 0.f;
#pragma unroll
        for (int d = 0; d < 64; ++d) ss += y[d] * y[d];
        LAS float* xch = (LAS float*)(lds + A_XCH);
        __syncthreads(); xch[tid] = ss; __syncthreads();
        ss += xch[tid ^ 256];
        const float li = layer == 0 ? 0.2f : 0.35550906759f;
        const float rs = rsqrtf(ss * (1.0f / 128.0f) + EPS) * (1.0f - li);
        const float* gs = in[16] + layer * 128 + 64 * dh;
        bf16_t* O = W.qB + (rowbase + qpos) * 512 + 128 * h + 64 * dh;
        __syncthreads();
#pragma unroll
        for (int d = 0; d < 64; d += 2) *(unsigned*)(O + d) = cvt_pk(y[d] * rs * gs[d], y[d + 1] * rs * gs[d + 1]);
    }
}

constexpr int ATT_UNITS = 16 * 80;
__device__ __forceinline__ void attn_phase(const WSP& W, const float* const* in, int layer, LAS unsigned char* lds) {
    unsigned* counter = W.ctl + 64 * (1 + layer);
    for (;;) {
        __syncthreads();
        if (threadIdx.x == 0) *(volatile LAS unsigned*)(lds + A_IDX) = atomicAdd(counter, 1u);
        __syncthreads();
        const int idx = (int)__builtin_amdgcn_readfirstlane(*(volatile LAS unsigned*)(lds + A_IDX));
        if (idx >= ATT_UNITS) break;
        int w, qb;
        if (idx < 256) { qb = 15 - idx / 16; w = idx % 16; } else if (idx < 768) { qb = 15 - (idx - 256) / 32; w = 16 + (idx - 256) % 32; } else { qb = 15 - (idx - 768) / 32; w = 48 + (idx - 768) % 32; }
        if (w < 16) {
            if (NAIVE_ATTN & 2) attn_unit_naive<1>(W, in, layer, w >> 2, w & 3, qb, lds); else attn_unit<1>(W, in, layer, w >> 2, w & 3, qb, lds);
        } else if (w < 48) {
            const int v = w - 16;
            if (NAIVE_ATTN & 1) attn_unit_naive<0>(W, in, layer, v >> 3, v & 7, qb, lds); else attn_unit<0>(W, in, layer, v >> 3, v & 7, qb, lds);
        } else {
            const int v = w - 48;
            if (NAIVE_ATTN & 4) attn_unit_naive<2>(W, in, layer, v >> 3, v & 7, qb, lds); else attn_unit<2>(W, in, layer, v >> 3, v & 7, qb, lds);
        }
    }
}

#define LANEINFO() int tid_ = threadIdx.x; asm volatile("" : "+v"(tid_)); const int lane = tid_ & 63, wave = __builtin_amdgcn_readfirstlane(tid_ >> 6); \
    const int NGW = gridDim.x * 8, gw = blockIdx.x * 8 + wave; (void)wave; (void)gw; (void)NGW; (void)lane
enum { MAP_ID = 0, MAP_SWIGLU = 1, MAP_WIN = 2, MAP_UQ = 3, MAP_UKV = 4 };
__device__ __forceinline__ void conv_item(const float* src, const float* src2, int K, int Nsrc, bf16_t* dst, int ldd, int kofs, int nblk, int map, const float* gain, int item, int lane) {
    const int npair = nblk >> 1, kb = item / npair, np = item % npair, k0 = 64 * kb, nb = 2 * np + (lane >> 5);
    int sc = 32 * nb; float scale = 1.0f; const float* S = src;
    if (map == MAP_SWIGLU) { const int tile = nb >> 3, w = nb & 7; if (w < 4) sc = 128 * tile + 32 * w; else { sc = 128 * tile + 32 * (w - 4); S = src2; } }
    else if (map == MAP_WIN) {
        if (nb < 12) sc = 32 * nb; else if (nb == 12) sc = 640; else if (nb < 16) sc = -1; else if (nb < 24) sc = 384 + 32 * (nb - 16);
        else if (nb < 40) { sc = 672 + 32 * (nb - 24); scale = 0.125f * LOG2E; } else if (nb < 56) { sc = 2208 + 32 * (nb - 40); scale = 0.125f * LOG2E; }
        else if (nb < 72) sc = 1184 + 32 * (nb - 56); else if (nb < 88) sc = 1696 + 32 * (nb - 72); else if (nb < 104) sc = 2720 + 32 * (nb - 88); else sc = 3232 + 32 * (nb - 104);
    } else if (map == MAP_UQ) { scale = 0.10206207261596575f * LOG2E; if (nb < 16) sc = 96 * (nb >> 1) + 32 * (nb & 1); else sc = 96 * (nb - 16) + 64; }
    else if (map == MAP_UKV) { if (nb < 16) sc = 128 * (nb >> 1) + 32 * (nb & 1); else sc = 128 * ((nb - 16) >> 1) + 64 + 32 * ((nb - 16) & 1); }
    const bool zero = sc < 0;
    const GAS float* base = (const GAS float*)S + (size_t)k0 * Nsrc + (zero ? 0 : sc) + (lane & 31);
    GAS bf16_t* drow = (GAS bf16_t*)dst + (size_t)(32 * nb + (lane & 31)) * ldd + kofs + k0;
    float v[64];
    int ns_v = Nsrc; asm volatile("" : "+v"(ns_v));
#pragma unroll
    for (int i = 0; i < 64; ++i) v[i] = base[(size_t)((unsigned)i * (unsigned)ns_v)];
#pragma unroll
    for (int c = 0; c < 8; ++c) {
        float w[8];
#pragma unroll
        for (int i = 0; i < 8; ++i) { float g = scale; if (gain) g *= ((const GAS float*)gain)[k0 + 8 * c + i]; w[i] = zero ? 0.f : v[8 * c + i] * g; }
        u32x4 o; o.x = cvt_pk(w[0], w[1]); o.y = cvt_pk(w[2], w[3]); o.z = cvt_pk(w[4], w[5]); o.w = cvt_pk(w[6], w[7]);
        *(GAS u32x4*)(drow + 8 * c) = o;
    }
}
__device__ __forceinline__ void conv_phase(const WSP& W, const float* const* in, int l, LAS unsigned char* lds) {
    LANEINFO();
    bf16_t* WB = W.WB; int base = 0;
    const size_t LW = (size_t)DM * FF;
#pragma unroll 1
    for (int j = 0; j < 16; ++j) {
        const float* src; const float* src2 = nullptr; const float* gain = nullptr; bf16_t* dst; int K = DM, Nsrc = DM, ldd = DM, kofs = 0, nblk = DM / 32, map = MAP_ID;
        switch (j) {
        case 0: src = in[3] + l * LW; src2 = in[4] + l * LW; Nsrc = FF; dst = WB + W_UPA; nblk = 2 * FF / 32; map = MAP_SWIGLU; gain = in[2] + l * DM; break;
        case 1: src = in[5] + l * LW; K = FF; dst = WB + W_DNA; ldd = FF; break;
        case 2: src = in[7] + (size_t)l * DM * 3744; Nsrc = 3744; dst = WB + W_IN; nblk = 3840 / 32; map = MAP_WIN; gain = in[6] + l * DM; break;
        case 3: src = in[20] + (size_t)l * DM * 3072; Nsrc = 3072; dst = WB + W_GATE; nblk = 3072 / 32; gain = in[6] + l * DM; break;
        case 4: src = in[10] + (size_t)l * 384 * 768; K = 384; Nsrc = 768; dst = WB + W_UQ; ldd = 384; nblk = 768 / 32; map = MAP_UQ; gain = in[8] + l * 384; break;
        case 5: src = in[11] + (size_t)l * 256 * 1024; K = 256; Nsrc = 1024; dst = WB + W_UKV; ldd = 256; nblk = 1024 / 32; map = MAP_UKV; gain = in[9] + l * 256; break;
        case 6: src = in[17] + (size_t)l * 512 * DM; K = 512; dst = WB + W_O; ldd = 512; break;
        case 7: src = in[18] + (size_t)l * 512 * DM; K = 512; dst = WB + W_O + 524288; ldd = 512; break;
        case 8: src = in[19] + (size_t)l * 512 * DM; K = 512; dst = WB + W_O + 2 * 524288; ldd = 512; break;
        case 9: src = in[21] + (size_t)l * DM * DM; dst = WB + W_OUT3; break;
        case 10: case 11: continue;
        case 12: src = in[23] + l * LW; src2 = in[24] + l * LW; Nsrc = FF; dst = WB + W_UPB; nblk = 2 * FF / 32; map = MAP_SWIGLU; gain = in[22] + l * DM; break;
        case 13: src = in[25] + l * LW; K = FF; dst = WB + W_DNB; ldd = FF; break;
        case 14: src = in[27] + (size_t)l * DM * DM; dst = WB + W_PG; gain = in[26] + l * DM; break;
        default: src = in[28] + (size_t)l * PLE * DM; K = PLE; dst = WB + W_PE; ldd = PLE; break;
        }
        const int n_ = (K / 64) * (nblk >> 1);
        for (int it_ = base + ((gw - base % NGW + NGW) % NGW); it_ < base + n_; it_ += NGW) conv_item(src, src2, K, Nsrc, dst, ldd, kofs, nblk, map, gain, it_ - base, lane);
        base += n_;
    }
    const GAS f32x4* ps = (const GAS f32x4*)(in[1] + (size_t)l * TOK * PLE);
    const int gt = gw * 64 + lane, NGT = NGW * 64;
    for (int i = gt; i < TOK * PLE / 8; i += NGT) { const f32x4 a = ps[2 * i], b = ps[2 * i + 1]; *(GAS u32x4*)(W.PBF + (size_t)i * 8) = pack8(a, b); }
}
__device__ __forceinline__ void prologue_phase(const WSP& W, const float* const* in) {
    LANEINFO();
    const int gt = gw * 64 + lane, NGT = NGW * 64;
    for (int e = gt; e < SEQ * 16; e += NGT) {
        const int pos = e >> 4, i = e & 15;
        const float freq = 1.0f / powf(10000.0f, (float)i * (1.0f / 16.0f));
        const float ang = (float)pos * freq;
        const double rev = (double)ang * 0.15915494309189535;
        const float fr = (float)(rev - rint(rev));
        ((GAS f32x2*)W.rope)[e] = (f32x2){__builtin_amdgcn_cosf(fr), __builtin_amdgcn_sinf(fr)};
    }
    const float* x = in[0];
    for (int row = gw; row < TOK; row += 2 * NGW) {
        const int row2 = row + NGW; const bool has2 = row2 < TOK;
        const GAS f32x4* xa = (const GAS f32x4*)(x + (size_t)row * DM); const GAS f32x4* xb = (const GAS f32x4*)(x + (size_t)(has2 ? row2 : row) * DM);
        f32x4 a[4], c[4];
#pragma unroll
        for (int j = 0; j < 2; ++j) { a[2 * j] = xa[128 * j + 2 * lane]; a[2 * j + 1] = xa[128 * j + 2 * lane + 1]; c[2 * j] = xb[128 * j + 2 * lane]; c[2 * j + 1] = xb[128 * j + 2 * lane + 1]; }
        float ss = 0.f, s2 = 0.f;
#pragma unroll
        for (int j = 0; j < 4; ++j) { ss += (a[j][0] * a[j][0] + a[j][1] * a[j][1]) + (a[j][2] * a[j][2] + a[j][3] * a[j][3]); s2 += (c[j][0] * c[j][0] + c[j][1] * c[j][1]) + (c[j][2] * c[j][2] + c[j][3] * c[j][3]); }
#pragma unroll
        for (int j = 0; j < 2; ++j) { *(GAS u32x4*)(W.HB2 + (size_t)row * DM + 512 * j + 8 * lane) = pack8(a[2 * j], a[2 * j + 1]);
            if (has2) *(GAS u32x4*)(W.HB2 + (size_t)row2 * DM + 512 * j + 8 * lane) = pack8(c[2 * j], c[2 * j + 1]); }
        ss = wave_sum(ss); s2 = wave_sum(s2);
        if (lane < 16) { ((GAS float*)W.stats0)[(size_t)row * 16 + lane] = (lane == 0) ? ss : 0.f; if (has2) ((GAS float*)W.stats0)[(size_t)row2 * 16 + lane] = (lane == 0) ? s2 : 0.f; }
    }
}
__device__ __forceinline__ void rope_k_phase(const WSP& W) {
    LANEINFO();
    const int sub = lane >> 4, i16 = lane & 15;
    for (int row = 4 * gw + sub; row < TOK; row += 4 * NGW) {
        GAS bf16_t* z = (GAS bf16_t*)(W.zA + (size_t)row * 768);
        const float x1 = bf2f(z[384 + i16]), x2 = bf2f(z[400 + i16]); const f32x2 cs = ((const GAS f32x2*)W.rope)[(size_t)(row & (SEQ - 1)) * 16 + i16];
        const unsigned o = cvt_pk(x1 * cs.x - x2 * cs.y, x2 * cs.x + x1 * cs.y);
        z[384 + i16] = (bf16_t)(o & 0xffffu); z[400 + i16] = (bf16_t)(o >> 16);
    }
}
__device__ __forceinline__ void final_phase(const WSP& W, const float* gfin, float* out) {
    LANEINFO();
    const GAS f32x4* g = (const GAS f32x4*)gfin;
    f32x4 gv[4];
#pragma unroll
    for (int j = 0; j < 2; ++j) { gv[2 * j] = g[128 * j + 2 * lane]; gv[2 * j + 1] = g[128 * j + 2 * lane + 1]; }
    for (int row = gw; row < TOK; row += 2 * NGW) {
        const int row2 = row + NGW; const bool has2 = row2 < TOK; const int rb = has2 ? row2 : row;
        const f32x4 sa = *(const GAS f32x4*)(W.stats0 + (size_t)row * 16 + 4 * (lane & 3)), sb = *(const GAS f32x4*)(W.stats0 + (size_t)rb * 16 + 4 * (lane & 3));
        const GAS u32x4* ha = (const GAS u32x4*)(W.HB2 + (size_t)row * DM); const GAS u32x4* hb = (const GAS u32x4*)(W.HB2 + (size_t)rb * DM);
        u32x4 wa[2], wb[2];
#pragma unroll
        for (int j = 0; j < 2; ++j) { wa[j] = ha[64 * j + lane]; wb[j] = hb[64 * j + lane]; }
        float s = (sa[0] + sa[1]) + (sa[2] + sa[3]); s += __shfl_xor(s, 1); s += __shfl_xor(s, 2);
        float t = (sb[0] + sb[1]) + (sb[2] + sb[3]); t += __shfl_xor(t, 1); t += __shfl_xor(t, 2);
        const float rs = rsqrtf(s * (1.0f / DM) + EPS), rt = rsqrtf(t * (1.0f / DM) + EPS);
        GAS f32x4* oa = (GAS f32x4*)(out + (size_t)row * DM); GAS f32x4* ob = (GAS f32x4*)(out + (size_t)rb * DM);
#pragma unroll
        for (int j = 0; j < 2; ++j) {
            const f32x4 a0 = (f32x4){bflo(wa[j].x), bfhi(wa[j].x), bflo(wa[j].y), bfhi(wa[j].y)}, a1 = (f32x4){bflo(wa[j].z), bfhi(wa[j].z), bflo(wa[j].w), bfhi(wa[j].w)};
            oa[128 * j + 2 * lane] = a0 * rs * gv[2 * j]; oa[128 * j + 2 * lane + 1] = a1 * rs * gv[2 * j + 1];
            if (has2) { const f32x4 b0 = (f32x4){bflo(wb[j].x), bfhi(wb[j].x), bflo(wb[j].y), bfhi(wb[j].y)}, b1 = (f32x4){bflo(wb[j].z), bfhi(wb[j].z), bflo(wb[j].w), bfhi(wb[j].w)};
                ob[128 * j + 2 * lane] = b0 * rt * gv[2 * j]; ob[128 * j + 2 * lane + 1] = b1 * rt * gv[2 * j + 1]; }
        }
    }
}

#define XB_TMO      128
#define XB_XCNT(j)  (256  + 64 * (j))
#define XB_XSUB(j)  (1280 + 64 * (j))
#define XB_XGEN(j)  (2304 + 64 * (j))
#define XB_TOP      3328
#define XB_TOPGEN   3392
#define XCD_BAR_WORDS 3456
#define XB_SPIN_CAP (1u << 18)

__device__ __forceinline__ unsigned xb_ld(unsigned* p)              { return __hip_atomic_load(p, __ATOMIC_RELAXED, __HIP_MEMORY_SCOPE_AGENT); }
__device__ __forceinline__ unsigned xb_add(unsigned* p, unsigned v) { return __hip_atomic_fetch_add(p, v, __ATOMIC_RELAXED, __HIP_MEMORY_SCOPE_AGENT); }
__device__ __forceinline__ unsigned xb_xcc_id() { return (unsigned)__builtin_amdgcn_s_getreg((3 << 11) | 20) & 0xFu; }
#define XB_SPIN(cond, bar) do { unsigned _sp = 0; while (cond) { __builtin_amdgcn_s_sleep(1); \
    if ((++_sp & 255u) == 0u) { if (xb_ld(&(bar)[XB_TMO])) break; if (_sp > XB_SPIN_CAP) { atomicAdd(&(bar)[XB_TMO], 1u); break; } } } } while (0)

struct XcdBarrier {
    unsigned* bar; unsigned x;
    volatile LAS unsigned* st;
};

__device__ __forceinline__ XcdBarrier xcd_barrier_post(unsigned* bar, volatile LAS unsigned* st) {
    XcdBarrier b; b.bar = bar; b.x = xb_xcc_id(); b.st = st;
    if (threadIdx.x == 0) (void)xb_add(&bar[XB_XCNT(b.x)], 1u);
    return b;
}
__device__ __forceinline__ void xcd_barrier_complete(unsigned* bar, unsigned x, unsigned& nloc, unsigned& nx) {
    const unsigned G = gridDim.x * gridDim.y * gridDim.z;
    unsigned sum, cnt, mine, sp = 0u;
    for (;;) {
        sum = 0u; cnt = 0u; mine = 0u;
#pragma unroll
        for (unsigned j = 0; j < 16; ++j) { const unsigned c = xb_ld(&bar[XB_XCNT(j)]); sum += c; cnt += (c > 0u) ? 1u : 0u; mine = (j == x) ? c : mine; }
        if (sum == G) break;
        __builtin_amdgcn_s_sleep(1);
        if ((++sp & 255u) == 0u) { if (xb_ld(&bar[XB_TMO])) break; if (sp > XB_SPIN_CAP) { atomicAdd(&bar[XB_TMO], 1u); break; } }
    }
    nloc = mine > 0u ? mine : 1u; nx = cnt > 0u ? cnt : 1u;
}

__device__ __forceinline__ void xcd_barrier(const XcdBarrier& b) {
    asm volatile("s_waitcnt vmcnt(0)" ::: "memory");
    __syncthreads();
    if (threadIdx.x == 0) {
        unsigned* bar = b.bar;
        __builtin_amdgcn_s_waitcnt(0);
        unsigned nloc = b.st[0], nx = b.st[1];
        if (nloc == 0u) { xcd_barrier_complete(bar, b.x, nloc, nx); b.st[0] = nloc; b.st[1] = nx; }
        const unsigned old = xb_add(&bar[XB_XSUB(b.x)], 1u);
        const unsigned gen = old / nloc;
        if (old + 1u == (gen + 1u) * nloc) {
            __builtin_amdgcn_fence(__ATOMIC_RELEASE, "agent");
            asm volatile("s_waitcnt vmcnt(0)" ::: "memory");
            const unsigned og = xb_add(&bar[XB_TOP], 1u);
            const unsigned tg = og / nx;
            if (og + 1u == (tg + 1u) * nx) xb_add(&bar[XB_TOPGEN], 1u);
            else XB_SPIN(xb_ld(&bar[XB_TOPGEN]) == tg, bar);
            __builtin_amdgcn_fence(__ATOMIC_ACQUIRE, "agent");
            xb_add(&bar[XB_XGEN(b.x)], 1u);
            asm volatile("s_waitcnt vmcnt(0)" ::: "memory");
        } else {
            XB_SPIN(xb_ld(&bar[XB_XGEN(b.x)]) == gen, bar);
            __builtin_amdgcn_fence(__ATOMIC_ACQUIRE, "agent");
            asm volatile("s_waitcnt vmcnt(0)" ::: "memory");
        }
    }
    __syncthreads();
}

constexpr int NTHREADS = 512, LDS_BYTES = 147456;
constexpr int PH_PER_LAYER = 12, PH_FINAL = 24, PH_TOTAL = 25;
struct Args { const float* in[30]; float* out; unsigned char* ws; int ph_lo, ph_hi; };

template <class Epi, class Sched>
__device__ __forceinline__ void run_gemm(LAS unsigned char* lds, const pg8::Gemm g, const Sched& S, const Epi& E) {
#if NAIVE_GEMM
    pg8::gemm_naive<Epi, Sched>(g, S, E);
#else
    pg8::gemm_phase<Epi, Sched, true, true>(lds, g, S, E);
#endif
}

__global__ void __launch_bounds__(NTHREADS, 2) fwd_megakernel(Args args) {
    extern __shared__ __attribute__((aligned(16))) unsigned char lds_raw[];
    LAS unsigned char* lds = (LAS unsigned char*)lds_raw;
    cg::grid_group grid = cg::this_grid();
    const int G = gridDim.x, bx = blockIdx.x;
#define MKW() unsigned char* ws = args.ws; asm volatile("" : "+s"(ws)); const float* const* in = args.in; WSP W; \
    W.ctl = (unsigned*)(ws + WS_CTL); W.rope = (f32x2*)(ws + WS_ROPE); W.stats0 = (float*)(ws + WS_STATS0); W.stats1 = (float*)(ws + WS_STATS1); W.statq = (float*)(ws + WS_STATQ); \
    W.WB = (bf16_t*)(ws + WS_WB); W.HB = (bf16_t*)(ws + WS_HB); W.HB2 = (bf16_t*)(ws + WS_HB2); W.PBF = (bf16_t*)(ws + WS_PBF); W.zA = (bf16_t*)(ws + WS_ZA); W.qM = (bf16_t*)(ws + WS_QM); \
    W.qB = (bf16_t*)(ws + WS_QB); W.qC = (bf16_t*)(ws + WS_QC); W.kB = (bf16_t*)(ws + WS_KB); W.vB = (bf16_t*)(ws + WS_VB); W.kC = (bf16_t*)(ws + WS_KC); W.vC = (bf16_t*)(ws + WS_VC); \
    W.kvM = (bf16_t*)(ws + WS_KVM); W.X = (bf16_t*)(ws + WS_X); W.FFH = (bf16_t*)(ws + WS_FFH); W.PE = (bf16_t*)(ws + WS_PE); W.Xm = (bf16_t*)(ws + WS_XM);
    float* out = args.out;
    const int lo = args.ph_lo, hi = args.ph_hi;
#define IN(k) (lo <= (k) && (k) < hi)
    constexpr size_t WS_BAR = 65536;
    LAS unsigned* bar_st = (LAS unsigned*)(lds + LDS_BYTES - 64);
    if (threadIdx.x < 2) bar_st[threadIdx.x] = 0u;
    __syncthreads();
    XcdBarrier xbar; xbar.bar = (unsigned*)(args.ws + WS_BAR); xbar.x = xb_xcc_id(); xbar.st = (volatile LAS unsigned*)bar_st;
#define SEAM(k) do { if ((k) + 1 < hi) { if ((k) == lo) { asm volatile("s_waitcnt vmcnt(0) lgkmcnt(0)" ::: "memory"); grid.sync(); \
        if (threadIdx.x == 0) { asm volatile("buffer_inv sc1\n\ts_waitcnt vmcnt(0)" ::: "memory"); (void)xb_add(&xbar.bar[XB_XCNT(xbar.x)], 1u); } __syncthreads(); } \
        else xcd_barrier(xbar); } } while (0)
    using pg8::Gemm; using pg8::StaticOrder; using pg8::PanelOrder;
#pragma unroll 1
    for (int l = 0; l < 2; ++l) {
        const int pb = PH_PER_LAYER * l;
        if (IN(pb + 0)) { MKW(); if (bx == 0 && threadIdx.x == 0) W.ctl[64 * (1 + l)] = 0u; if (bx == 0 && l == 0) { int t0_ = threadIdx.x; asm volatile("" : "+v"(t0_)); for (int k_ = 0; k_ < (XCD_BAR_WORDS + NTHREADS - 1) / NTHREADS; ++k_) { const int i_ = t0_ + NTHREADS * k_; if (i_ < XCD_BAR_WORDS) ((GAS unsigned*)(args.ws + 65536))[i_] = 0u; } }     conv_phase(W, in, l, lds); if (l == 0) prologue_phase(W, in); __syncthreads(); SEAM(pb + 0); }
        if (IN(pb + 1)) { MKW(); Gemm g{W.HB2, W.WB + W_UPA, TOK, 2 * FF, DM, DM}; StaticOrder S; S.init(TOK, 2 * FF, G, bx);
            EpiSwiglu E{W.FFH, W.stats0}; run_gemm(lds, g, S, E); SEAM(pb + 1); }
        if (IN(pb + 2)) { MKW(); Gemm g{W.FFH, W.WB + W_DNA, TOK, DM, FF, FF}; StaticOrder S; S.init(TOK, DM, G, bx);
            EpiResid<false> E{W.HB2, W.HB, W.stats1, 0.5f, nullptr, nullptr}; run_gemm(lds, g, S, E); SEAM(pb + 2); }
        if (IN(pb + 3)) { MKW(); Gemm g{W.HB, W.WB + W_IN, TOK, 3840, DM, DM}; StaticOrder S; S.init(TOK, 3840, G, bx);
            EpiInproj E{W.zA, W.qB, W.stats1, W.statq}; run_gemm(lds, g, S, E); SEAM(pb + 3); }
        if (IN(pb + 5)) { MKW();
            rope_k_phase(W);
            { Gemm g{W.zA, W.WB + W_UQ, TOK, 768, 384, 768}; StaticOrder S; S.init(TOK, 768, G, bx); EpiStore E{W.qM, 768, W.statq, 1}; run_gemm(lds, g, S, E); }
            { Gemm g{W.zA + 512, W.WB + W_UKV, TOK, 1024, 256, 768}; StaticOrder S; S.init(TOK, 1024, G, bx); EpiStore E{W.kvM, 1024, W.statq, 2}; run_gemm(lds, g, S, E); }
            SEAM(pb + 5); }
        if (IN(pb + 6)) { MKW(); attn_phase(W, in, l, lds); SEAM(pb + 6); }
        if (IN(pb + 7)) { MKW();
            for (int tile = bx; tile < 256; tile += G) {
                const int pm = 8 * (tile & 7) + ((tile >> 3) & 7), pnq = tile >> 6;
                { Gemm g{W.HB, W.WB + W_GATE, TOK, 3072, DM, DM}; PanelOrder S{pm, pnq, 4, 3}; EpiGates E{W.X, W.stats1}; run_gemm(lds, g, S, E); }
                { Gemm g{W.qM, W.WB + W_O, TOK, DM, 512, 768}; PanelOrder S{pm, pnq, 0, 1}; EpiMulGateAcc E{W.X, W.Xm, 0}; run_gemm(lds, g, S, E); }
                { Gemm g{W.qB, W.WB + W_O + 524288, TOK, DM, 512, 512}; PanelOrder S{pm, pnq, 0, 1}; EpiMulGateAcc E{W.X, W.Xm, 1}; run_gemm(lds, g, S, E); }
                { Gemm g{W.qC, W.WB + W_O + 2 * 524288, TOK, DM, 512, 512}; PanelOrder S{pm, pnq, 0, 1}; EpiMulGateAcc E{W.X, W.Xm, 2}; run_gemm(lds, g, S, E); }
            }
            SEAM(pb + 7); }
        if (IN(pb + 8)) { MKW(); Gemm g{W.Xm, W.WB + W_OUT3, TOK, DM, DM, DM}; StaticOrder S; S.init(TOK, DM, G, bx);
            EpiResid<false> E{W.HB, W.HB, W.stats0, 1.0f, nullptr, nullptr}; run_gemm(lds, g, S, E); SEAM(pb + 8); }
        if (IN(pb + 9)) { MKW(); Gemm g{W.HB, W.WB + W_UPB, TOK, 2 * FF, DM, DM}; StaticOrder S; S.init(TOK, 2 * FF, G, bx);
            EpiSwiglu E{W.FFH, W.stats0}; run_gemm(lds, g, S, E);
            { const int G2 = G - G / 2; Gemm g2{W.PBF, W.WB + W_PE, TOK, DM, PLE, PLE}; StaticOrder S2; S2.init(TOK, DM, G2, bx >= G / 2 ? bx - G / 2 : (1 << 20)); EpiStore E2{W.PE, DM, nullptr, 0}; run_gemm(lds, g2, S2, E2); }
            SEAM(pb + 9); }
        if (IN(pb + 10)) { MKW();
            { Gemm g{W.FFH, W.WB + W_DNB, TOK, DM, FF, FF}; StaticOrder S; S.init(TOK, DM, G, bx); EpiResid<false> E{W.HB, W.HB, W.stats1, 0.5f, nullptr, nullptr}; run_gemm(lds, g, S, E); }
            SEAM(pb + 10); }
        if (IN(pb + 11)) { MKW(); Gemm g{W.HB, W.WB + W_PG, TOK, DM, DM, DM}; StaticOrder S; S.init(TOK, DM, G, bx);
            EpiResid<true> E{W.HB, W.HB2, W.stats0, 1.0f, W.stats1, W.PE}; run_gemm(lds, g, S, E); SEAM(pb + 11); }
    }
    if (IN(PH_FINAL)) { MKW(); final_phase(W, in[29], out); }
#undef IN
#undef SEAM
}

extern "C" void kernel_launch(void* const* d_in, const int* in_sizes, int n_in, void* d_out, int out_size, void* d_ws, size_t ws_size, hipStream_t stream) {
    static int grid = 0;
    if (grid == 0) {
        if (n_in != 30 || out_size != TOK * DM || ws_size < WS_END) { fprintf(stderr, "kernel_launch: unexpected problem (n_in %d, out %d, ws %zu)\n", n_in, out_size, ws_size); grid = -1; return; }
        int dev = 0, cus = 0, per_cu = 0;
        hipGetDevice(&dev); hipDeviceGetAttribute(&cus, hipDeviceAttributeMultiprocessorCount, dev);
        if (hipFuncSetAttribute((const void*)fwd_megakernel, hipFuncAttributeMaxDynamicSharedMemorySize, LDS_BYTES) != hipSuccess) { fprintf(stderr, "kernel_launch: hipFuncSetAttribute failed\n"); grid = -1; return; }
        if (hipOccupancyMaxActiveBlocksPerMultiprocessor(&per_cu, (const void*)fwd_megakernel, NTHREADS, LDS_BYTES) != hipSuccess || per_cu < 1) per_cu = 1;
        (void)hipGetLastError();
        grid = cus * per_cu;
        if (grid > 256) grid = 256;
    }
    if (grid < 0) return;
    Args a{};
    for (int i = 0; i < 30; ++i) a.in[i] = (const float*)d_in[i];
    a.out = (float*)d_out; a.ws = (unsigned char*)d_ws;
#if N_LAUNCH_MODE
    a.ph_lo = 0; a.ph_hi = PH_TOTAL;
    void* kargs[] = {&a};
    hipError_t e = hipLaunchCooperativeKernel((const void*)fwd_megakernel, dim3(grid), dim3(NTHREADS), kargs, LDS_BYTES, stream);
    if (e != hipSuccess) fprintf(stderr, "cooperative launch failed: %s (grid %d)\n", hipGetErrorString(e), grid);
#else
    for (int p = 0; p < PH_TOTAL; ++p) { a.ph_lo = p; a.ph_hi = p + 1; hipLaunchKernelGGL(fwd_megakernel, dim3(grid), dim3(NTHREADS), LDS_BYTES, stream, a); }
#endif
}
```
